# Optimizing an MI355X kernel written in HIP

```python
import math
import jax, jax.numpy as jnp
from jax import lax
import numpy as np

D_MODEL = 1024
BATCH = 1
SEQ = 16384
DEPTH = 4
DEC_BATCH = 32
DEC_SEQ = 16
PAST_LEN = 4096

CHUNK = 64
D_MIX = D_MODEL
D_A = D_MIX // 2
G_A = 4
C_A = D_A // G_A
GMLP_BLOCK = 128
D_B = D_MIX - D_A
H_B = 4
DK = D_B // H_B
DV = DK
CONV_W = 4
D_QKV = 3 * D_B
DN_CHUNK = 64
D_FF = -(-8 * D_MODEL // (3 * 256)) * 256
D_IN = 2 * D_A + 4 * D_B + 2 * H_B
EPS = 1e-6

kernel_name = "hymba_gmlp_gated_deltanet_stream_step"


def rms_norm(x, g):
    xf = x.astype(jnp.float32)
    y = xf * lax.rsqrt(jnp.mean(xf * xf, axis=-1, keepdims=True) + EPS)
    return (y * g.astype(jnp.float32)).astype(x.dtype)


def l2norm(x):
    xf = x.astype(jnp.float32)
    return xf * lax.rsqrt(jnp.sum(xf * xf, axis=-1, keepdims=True) + EPS)


def causal_conv(xin, buf, w):
    L = xin.shape[1]
    xp = jnp.concatenate([buf.astype(xin.dtype), xin], axis=1)
    y = xp[:, 0:L] * w[0]
    for i in range(1, CONV_W):
        y = y + xp[:, i:i + L] * w[i]
    return y, xp[:, -(CONV_W - 1):]


def gmlp_spatial(u, v, w_s, b_s, blk):
    B, L, _ = v.shape
    nb = L // blk
    vb = v.reshape(B, nb, blk, G_A, C_A)
    ub = u.reshape(B, nb, blk, G_A, C_A)
    pos = jnp.arange(blk)
    mask = (pos[None, :] // CHUNK) <= (pos[:, None] // CHUNK)
    ws = jnp.where(mask, w_s[:, :blk, :blk], 0)
    s = jnp.einsum('gij,bnjgc->bnigc', ws, vb) + b_s[:, :blk].T[:, :, None]
    return (ub * s).reshape(B, L, D_A)


def gated_delta_chunked(q, k, v, g, beta, S0, chunk):
    B, L, H, _ = q.shape
    nc = L // chunk

    def blocks(t):
        return jnp.swapaxes(t.reshape((B, nc, chunk) + t.shape[2:]), 2, 3)

    q, k, v = blocks(q), blocks(k), blocks(v)
    beta = blocks(beta)
    bcum = jnp.cumsum(blocks(g), axis=-1)
    idx = jnp.arange(chunk)
    diff = bcum[..., :, None] - bcum[..., None, :]
    dec_strict = jnp.exp(jnp.where(idx[:, None] > idx[None, :], diff, -jnp.inf))
    dec_incl = jnp.exp(jnp.where(idx[:, None] >= idx[None, :], diff, -jnp.inf))
    M = beta[..., :, None] * jnp.einsum('bnhid,bnhjd->bnhij', k, k) * dec_strict
    T = M + jnp.eye(chunk, dtype=M.dtype)
    rhs = jnp.concatenate([v * beta[..., None], k * (beta * jnp.exp(bcum))[..., None]], axis=-1)
    sol = lax.linalg.triangular_solve(T, rhs, left_side=True, lower=True)
    u, w = sol[..., :DV], sol[..., DV:]
    attn = jnp.einsum('bnhid,bnhjd->bnhij', q, k) * dec_incl
    q_dec = q * jnp.exp(bcum)[..., None]
    b_last = bcum[..., -1:]
    k_dec = k * jnp.exp(b_last - bcum)[..., None]
    g_last = jnp.exp(b_last[..., 0])
    xs = tuple(jnp.moveaxis(t, 1, 0) for t in (u, w, attn, q_dec, k_dec, g_last))

    def step(S, inp):
        u_c, w_c, a_c, qd, kd, gl = inp
        delta = u_c - jnp.einsum('bhik,bhkv->bhiv', w_c, S)
        o = jnp.einsum('bhik,bhkv->bhiv', qd, S) + jnp.einsum('bhij,bhjv->bhiv', a_c, delta)
        S = gl[..., None, None] * S + jnp.einsum('bhik,bhiv->bhkv', kd, delta)
        return S, o

    S_fin, o = lax.scan(step, S0, xs)
    o = jnp.swapaxes(jnp.moveaxis(o, 0, 1), 2, 3).reshape(B, L, H, DV)
    return o, S_fin


def layer(x, conv_buf, S0, blk, w_in, conv_w, a_log, dt_bias, gdn_norm, gmlp_ws, gmlp_bs,
          gmlp_norm, w_o, norm1, norm2, w_gate, w_up, w_down):
    B, L, _ = x.shape
    h = rms_norm(x, norm1)
    p = h @ w_in
    o1 = 2 * D_A
    o2 = o1 + D_QKV
    o3 = o2 + D_B
    o4 = o3 + H_B
    u_a, v_a, qkv, z, b_raw, a_raw = jnp.split(p, [D_A, o1, o2, o3, o4], axis=-1)
    u_a = jax.nn.gelu(u_a)
    v_a = jax.nn.gelu(v_a)
    y_a = gmlp_spatial(u_a, v_a, gmlp_ws, gmlp_bs, blk)
    y_a = rms_norm(y_a.reshape(B, L, G_A, C_A), gmlp_norm.reshape(G_A, C_A)).reshape(B, L, D_A)
    qkv_c, new_buf = causal_conv(qkv, conv_buf, conv_w)
    qkv_c = jax.nn.silu(qkv_c)
    q, k, v = jnp.split(qkv_c, 3, axis=-1)
    q = l2norm(q.reshape(B, L, H_B, DK)) * (DK ** -0.5)
    k = l2norm(k.reshape(B, L, H_B, DK))
    v = v.reshape(B, L, H_B, DV).astype(jnp.float32)
    beta = jax.nn.sigmoid(b_raw.astype(jnp.float32))
    g = -jnp.exp(a_log.astype(jnp.float32)) * jax.nn.softplus(a_raw.astype(jnp.float32) + dt_bias.astype(jnp.float32))
    chunk = DN_CHUNK if L % DN_CHUNK == 0 else L
    o, S_new = gated_delta_chunked(q, k, v, g, beta, S0.astype(jnp.float32), chunk)
    o = rms_norm(o, gdn_norm) * jax.nn.silu(z.reshape(B, L, H_B, DV).astype(jnp.float32))
    y_b = o.reshape(B, L, D_B).astype(x.dtype)
    x = x + jnp.concatenate([y_a, y_b], axis=-1) @ w_o
    h2 = rms_norm(x, norm2)
    x = x + (jax.nn.silu(h2 @ w_gate) * (h2 @ w_up)) @ w_down
    return x, new_buf, S_new.astype(S0.dtype), v_a


def setup_inputs(seed: int = 0) -> dict:
    key = jax.random.key(seed)
    ks = jax.random.split(key, 24)

    def nrm(k, shape, s):
        return jax.random.normal(k, shape, jnp.float32) * s

    dt = jnp.exp(jax.random.uniform(ks[7], (DEPTH, H_B), jnp.float32, math.log(1e-3), math.log(1e-1)))
    return {
        "x_prompt": nrm(ks[0], (BATCH, SEQ, D_MODEL), 1.0),
        "x_sample": nrm(ks[1], (DEC_BATCH, DEC_SEQ, D_MODEL), 1.0),
        "state_gdn": nrm(ks[2], (DEPTH, DEC_BATCH, H_B, DK, DV), 0.3),
        "state_conv": nrm(ks[3], (DEPTH, DEC_BATCH, CONV_W - 1, D_QKV), 1.0),
        "w_in": nrm(ks[4], (DEPTH, D_MODEL, D_IN), D_MODEL ** -0.5),
        "conv_w": nrm(ks[5], (DEPTH, CONV_W, D_QKV), CONV_W ** -0.5),
        "a_log": jnp.log(jax.random.uniform(ks[6], (DEPTH, H_B), jnp.float32, 1.0, 16.0)),
        "dt_bias": dt + jnp.log(-jnp.expm1(-dt)),
        "gdn_norm": 1.0 + nrm(ks[8], (DEPTH, DV), 0.05),
        "gmlp_ws": nrm(ks[9], (DEPTH, G_A, GMLP_BLOCK, GMLP_BLOCK), GMLP_BLOCK ** -0.5),
        "gmlp_bs": 1.0 + nrm(ks[10], (DEPTH, G_A, GMLP_BLOCK), 0.05),
        "gmlp_norm": 1.0 + nrm(ks[11], (DEPTH, D_A), 0.05),
        "w_o": nrm(ks[12], (DEPTH, D_MIX, D_MODEL), D_MIX ** -0.5),
        "norm1": 1.0 + nrm(ks[13], (DEPTH, D_MODEL), 0.05),
        "norm2": 1.0 + nrm(ks[14], (DEPTH, D_MODEL), 0.05),
        "w_gate": nrm(ks[15], (DEPTH, D_MODEL, D_FF), D_MODEL ** -0.5),
        "w_up": nrm(ks[16], (DEPTH, D_MODEL, D_FF), D_MODEL ** -0.5),
        "w_down": nrm(ks[17], (DEPTH, D_FF, D_MODEL), D_FF ** -0.5),
        "final_norm": 1.0 + nrm(ks[18], (D_MODEL,), 0.05),
    }


def reference(x_prompt, x_sample, state_gdn, state_conv, w_in, conv_w, a_log, dt_bias, gdn_norm,
              gmlp_ws, gmlp_bs, gmlp_norm, w_o, norm1, norm2, w_gate, w_up, w_down, final_norm):
    xp = x_prompt
    xs = x_sample
    bp = xp.shape[0]
    gdn_p, conv_p, gdn_s, conv_s, v_s = [], [], [], [], []
    for l in range(DEPTH):
        params = (w_in[l], conv_w[l], a_log[l], dt_bias[l], gdn_norm[l], gmlp_ws[l], gmlp_bs[l],
                  gmlp_norm[l], w_o[l], norm1[l], norm2[l], w_gate[l], w_up[l], w_down[l])
        buf0 = jnp.zeros((bp, CONV_W - 1, D_QKV), xp.dtype)
        S0 = jnp.zeros((bp, H_B, DK, DV), state_gdn.dtype)
        xp, cb, Sp, _ = layer(xp, buf0, S0, GMLP_BLOCK, *params)
        gdn_p.append(Sp)
        conv_p.append(cb)
        xs, cbs, Ss, va = layer(xs, state_conv[l], state_gdn[l], xs.shape[1], *params)
        gdn_s.append(Ss)
        conv_s.append(cbs)
        v_s.append(va)
    y_prompt = rms_norm(xp, final_norm)
    y_sample = rms_norm(xs, final_norm)
    return (y_prompt, y_sample, jnp.stack(gdn_p), jnp.stack(conv_p), jnp.stack(gdn_s), jnp.stack(conv_s), jnp.stack(v_s))
```

```cpp
#include <hip/hip_runtime.h>
#include <hip/hip_cooperative_groups.h>
#include <cstdio>
#include <cstdint>
namespace cg = cooperative_groups;
namespace pg8 {
#define PG8_LAS __attribute__((address_space(3)))
typedef unsigned short bf16_t;
typedef short bf16x8 __attribute__((ext_vector_type(8)));
typedef float f32x4 __attribute__((ext_vector_type(4)));
typedef unsigned u32x4 __attribute__((ext_vector_type(4)));
constexpr int BM = 256, BK = 64, HALF = 128, HTB = HALF * BK * 2  , STAGE_BYTES = 8 * HTB, NXCD = 8, WGM = 8;

__host__ __device__ __forceinline__ int lds_byte(int r, int c) { const int st = (r >> 4) * 2 + (c >> 5), rr = r & 15, cc = c & 31, ob = rr * 64 + cc * 2; return st * 1024 + (ob ^ (((ob >> 9) & 1) << 5)); }
__host__ __device__ __forceinline__ void stage_rc(int b, int& R, int& C) { const int st = b / 1024, sb = b % 1024, swz = sb ^ (((sb >> 9) & 1) << 5); R = (st >> 1) * 16 + swz / 64; C = (st & 1) * 32 + (swz % 64) / 2; }
__host__ __device__ __forceinline__ int perm32(int rho) { const int n = rho >> 4, i = rho & 15; return 8 * (i >> 2) + 4 * n + (i & 3); }

struct Unit { int pm, pn, koff; };
struct Gemm { const bf16_t* A; const bf16_t* Bt; int M, N, K, ld; };

struct StaticOrder {
    int nM, nN, nwg, G, c;
    __host__ __device__ void init(int M, int N, int G_, int c_) { nM = M / BM; nN = N / BM; nwg = nM * nN; G = G_; c = c_; }
    __host__ __device__ bool next(int i, Unit& u) const {
        const long L = (long)i * G + c; if (L >= nwg) return false;
        int wgid = (int)L; { const int q = nwg / NXCD, r = nwg % NXCD, xcd = wgid % NXCD, off = wgid / NXCD; wgid = (xcd < r ? xcd * (q + 1) : r * (q + 1) + (xcd - r) * q) + off; }
        const int nig = WGM * nN, gid = wgid / nig, fm = gid * WGM, gsz = (nM - fm) < WGM ? (nM - fm) : WGM;
        u.pm = fm + ((wgid % nig) % gsz); u.pn = (wgid % nig) / gsz; u.koff = 0; return true;
    }
    __device__ __forceinline__ void a_ready(const Unit&) const {}
    __device__ __forceinline__ void done(const Unit&) const {}
};

typedef float f32x2_t __attribute__((ext_vector_type(2))); typedef __bf16 bf16x2_t __attribute__((ext_vector_type(2)));
__device__ __forceinline__ unsigned cvt_pk_bf16(float lo, float hi) { f32x2_t v = {lo, hi}; bf16x2_t b = __builtin_convertvector(v, bf16x2_t); return __builtin_bit_cast(unsigned, b); }

template <class Epi, class Sched, bool ALIGN_EPI = false, bool SP2 = false>
__device__ __forceinline__ void gemm_phase(PG8_LAS unsigned char* lds, const Gemm g, const Sched& S, const Epi& E, const int tid_arg) {
    int tid_ = tid_arg; asm volatile("" : "+v"(tid_)); const int tid = tid_, wid = __builtin_amdgcn_readfirstlane(tid >> 6), lane = tid & 63, wr = wid >> 2, wc = wid & 3, fr = lane & 15, fq = lane >> 4;
    const int K = g.ld, nt = g.K / BK;
    unsigned voffA[2], voffB[2];
#pragma unroll
    for (int i = 0; i < 2; ++i) { int R, C; stage_rc(tid * 16 + i * 8192, R, C); const int Rb = Epi::PERM ? ((R & ~31) + perm32(R & 31)) : R;
        voffA[i] = (unsigned)(R * K + C) * 2u; voffB[i] = (unsigned)(Rb * K + C) * 2u; }
    const size_t kstep = (size_t)(BK * 2);
    const size_t hstep = (size_t)HALF * K * 2;
    const size_t tstep = 2 * hstep;
    const unsigned ldsw = (unsigned)wid * 1024u;
    const int aoff = lds_byte(wr * 64 + fr, fq * 8), boff = lds_byte(wc * 32 + fr, fq * 8);
#define PG8_SA(b, h) (((b) * 2 + (h)) * HTB)
#define PG8_SB(b, h) ((4 + (b) * 2 + (h)) * HTB)
#define PG8_STAGE(bufoff, gbase, voff) do { _Pragma("unroll") for (int _i = 0; _i < 2; ++_i) \
        __builtin_amdgcn_global_load_lds((const unsigned*)((const char*)(gbase) + (voff)[_i]), (PG8_LAS unsigned*)(lds + (bufoff) + ldsw + _i * 8192), 16, 0, 0); } while (0)
#define PG8_LDA(dst, b, h) do { _Pragma("unroll") for (int m = 0; m < 4; ++m) _Pragma("unroll") for (int k = 0; k < 2; ++k) dst[m][k] = *(const PG8_LAS bf16x8*)(lds + PG8_SA(b, h) + aoff + m * 2048 + k * 1024); } while (0)
#define PG8_LDB(dst, b, h) do { _Pragma("unroll") for (int n = 0; n < 2; ++n) _Pragma("unroll") for (int k = 0; k < 2; ++k) dst[n][k] = *(const PG8_LAS bf16x8*)(lds + PG8_SB(b, h) + boff + n * 2048 + k * 1024); } while (0)
#define PG8_MMA(ai, bj, At, Bt) do { __builtin_amdgcn_s_setprio(1); _Pragma("unroll") for (int m = 0; m < 4; ++m) _Pragma("unroll") for (int n = 0; n < 2; ++n) _Pragma("unroll") for (int k = 0; k < 2; ++k) \
        acc[ai][bj][m][n] = __builtin_amdgcn_mfma_f32_16x16x32_bf16(Bt[n][k], At[m][k], acc[ai][bj][m][n], 0, 0, 0); __builtin_amdgcn_s_setprio(0); } while (0)
#define PG8_WAIT_V(n) asm volatile("s_waitcnt vmcnt(" #n ")" ::: "memory")
#define PG8_WAIT_L(n) asm volatile("s_waitcnt lgkmcnt(" #n ")" ::: "memory")
#define PG8_BAR __builtin_amdgcn_s_barrier()
#define PG8_SCHED __builtin_amdgcn_sched_barrier(0)
    Unit cur, nxt; int ui = 0;
    if (!S.next(0, cur)) return;
    f32x4 acc[2][2][4][2];
#pragma unroll
    for (int a = 0; a < 2; ++a)
#pragma unroll
        for (int b = 0; b < 2; ++b)
#pragma unroll
            for (int m = 0; m < 4; ++m)
#pragma unroll
                for (int n = 0; n < 2; ++n) acc[a][b][m][n] = (f32x4){0.f, 0.f, 0.f, 0.f};
    bf16x8 At[4][2], B0[2][2], B1[2][2];
    const char* cA = (const char*)g.A + (size_t)cur.pm * tstep + (size_t)cur.koff * 2; const char* cB = (const char*)g.Bt + (size_t)cur.pn * tstep + (size_t)cur.koff * 2;
    S.a_ready(cur);
    if constexpr (SP2) {
        PG8_STAGE(PG8_SB(0, 0), cB, voffB); PG8_STAGE(PG8_SB(0, 1), cB + hstep, voffB); PG8_STAGE(PG8_SA(0, 0), cA, voffA); PG8_STAGE(PG8_SA(0, 1), cA + hstep, voffA);
        if (wr == 1) PG8_BAR;
        PG8_WAIT_V(2); PG8_BAR;
        PG8_STAGE(PG8_SB(1, 0), cB + kstep, voffB); PG8_STAGE(PG8_SA(1, 0), cA + kstep, voffA); PG8_STAGE(PG8_SB(1, 1), cB + hstep + kstep, voffB);
        PG8_WAIT_V(6); PG8_BAR;
    } else {
        PG8_STAGE(PG8_SB(0, 0), cB, voffB); PG8_STAGE(PG8_SA(0, 0), cA, voffA); PG8_STAGE(PG8_SB(0, 1), cB + hstep, voffB); PG8_STAGE(PG8_SA(0, 1), cA + hstep, voffA);
        if (wr == 1) PG8_BAR;
        PG8_WAIT_V(4); PG8_BAR;
        PG8_STAGE(PG8_SB(1, 0), cB + kstep, voffB); PG8_STAGE(PG8_SA(1, 0), cA + kstep, voffA); PG8_STAGE(PG8_SB(1, 1), cB + hstep + kstep, voffB);
        PG8_WAIT_V(6); PG8_BAR;
    }
    for (;;) {
        const bool has_next = S.next(ui + 1, nxt);
        const char* nA = has_next ? (const char*)g.A + (size_t)nxt.pm * tstep + (size_t)nxt.koff * 2 : cA; const char* nB = has_next ? (const char*)g.Bt + (size_t)nxt.pn * tstep + (size_t)nxt.koff * 2 : cB;
        for (int t = 0; t < nt; t += 2) {
            const bool last = (t == nt - 2);
            const char* a1 = cA + (size_t)(t + 1) * kstep;
            const char* a2 = last ? nA : cA + (size_t)(t + 2) * kstep; const char* b2 = last ? nB : cB + (size_t)(t + 2) * kstep;
            const char* a3 = a2 + kstep; const char* b3 = b2 + kstep;
            if (last && has_next) S.a_ready(nxt);
            if constexpr (SP2) {
            PG8_LDB(B0, 0, 0); PG8_LDB(B1, 0, 1); PG8_SCHED; PG8_LDA(At, 0, 0); PG8_STAGE(PG8_SA(1, 1), a1 + hstep, voffA);
            PG8_WAIT_V(8); PG8_WAIT_L(0); PG8_BAR; PG8_MMA(0, 0, At, B0); PG8_MMA(0, 1, At, B1); PG8_BAR; PG8_SCHED;
            PG8_LDA(At, 0, 1); PG8_STAGE(PG8_SB(0, 0), b2, voffB); PG8_STAGE(PG8_SB(0, 1), b2 + hstep, voffB); PG8_STAGE(PG8_SA(0, 0), a2, voffA);
            PG8_WAIT_V(8); PG8_WAIT_L(0); PG8_BAR; PG8_MMA(1, 0, At, B0); PG8_MMA(1, 1, At, B1); PG8_BAR; PG8_SCHED;
            PG8_LDB(B0, 1, 0); PG8_LDB(B1, 1, 1); PG8_SCHED; PG8_LDA(At, 1, 0); PG8_STAGE(PG8_SA(0, 1), a2 + hstep, voffA);
            PG8_WAIT_V(8); PG8_WAIT_L(0); PG8_BAR; PG8_MMA(0, 0, At, B0); PG8_MMA(0, 1, At, B1); PG8_BAR; PG8_SCHED;
            PG8_LDA(At, 1, 1); PG8_STAGE(PG8_SB(1, 0), b3, voffB); PG8_STAGE(PG8_SB(1, 1), b3 + hstep, voffB); PG8_STAGE(PG8_SA(1, 0), a3, voffA);
            PG8_WAIT_V(8); PG8_WAIT_L(0); PG8_BAR; PG8_MMA(1, 0, At, B0); PG8_MMA(1, 1, At, B1); PG8_BAR; PG8_SCHED;
            } else {
            PG8_LDB(B0, 0, 0); PG8_SCHED; PG8_LDA(At, 0, 0); PG8_STAGE(PG8_SA(1, 1), a1 + hstep, voffA);
            PG8_WAIT_L(8); PG8_BAR; PG8_WAIT_L(0); PG8_MMA(0, 0, At, B0); PG8_BAR; PG8_SCHED;
            PG8_LDB(B1, 0, 1); PG8_STAGE(PG8_SB(0, 0), b2, voffB);
            PG8_BAR; PG8_WAIT_L(0); PG8_MMA(0, 1, At, B1); PG8_BAR;
            PG8_LDA(At, 0, 1); PG8_STAGE(PG8_SA(0, 0), a2, voffA);
            PG8_BAR; PG8_WAIT_L(0); PG8_MMA(1, 0, At, B0); PG8_BAR; PG8_SCHED;
            PG8_STAGE(PG8_SB(0, 1), b2 + hstep, voffB);
            PG8_WAIT_V(6); PG8_BAR; PG8_MMA(1, 1, At, B1); PG8_BAR;
            PG8_LDB(B0, 1, 0); PG8_SCHED; PG8_LDA(At, 1, 0); PG8_STAGE(PG8_SA(0, 1), a2 + hstep, voffA);
            PG8_WAIT_L(8); PG8_BAR; PG8_WAIT_L(0); PG8_MMA(0, 0, At, B0); PG8_BAR; PG8_SCHED;
            PG8_LDB(B1, 1, 1); PG8_STAGE(PG8_SB(1, 0), b3, voffB);
            PG8_BAR; PG8_WAIT_L(0); PG8_MMA(0, 1, At, B1); PG8_BAR;
            PG8_LDA(At, 1, 1); PG8_STAGE(PG8_SA(1, 0), a3, voffA);
            PG8_BAR; PG8_WAIT_L(0); PG8_MMA(1, 0, At, B0); PG8_BAR; PG8_SCHED;
            PG8_STAGE(PG8_SB(1, 1), b3 + hstep, voffB);
            PG8_WAIT_V(6); PG8_BAR; PG8_MMA(1, 1, At, B1); PG8_BAR;
            }
        }
        if constexpr (ALIGN_EPI) { if (wr == 0) PG8_BAR; }
        if constexpr (!Epi::AFTER_DRAIN) { E(acc, cur, wr, wc, fr, fq); S.done(cur); }
        if (!has_next) break;
#pragma unroll
        for (int a = 0; a < 2; ++a)
#pragma unroll
            for (int b = 0; b < 2; ++b)
#pragma unroll
                for (int m = 0; m < 4; ++m)
#pragma unroll
                    for (int n = 0; n < 2; ++n) acc[a][b][m][n] = (f32x4){0.f, 0.f, 0.f, 0.f};
        cur = nxt; cA = nA; cB = nB; ++ui;
        if constexpr (ALIGN_EPI) { if (wr == 1) PG8_BAR; }
    }
    PG8_WAIT_V(0);
    if constexpr (!ALIGN_EPI) { if (wr == 0) PG8_BAR; }
    PG8_BAR;
    if constexpr (Epi::AFTER_DRAIN) { E.fused(acc, cur, wr, wc, fr, fq, lds, wid, lane); S.done(cur); }
#undef PG8_SA
#undef PG8_SB
#undef PG8_STAGE
#undef PG8_LDA
#undef PG8_LDB
#undef PG8_MMA
#undef PG8_WAIT_V
#undef PG8_WAIT_L
#undef PG8_BAR
#undef PG8_SCHED
}
}

#ifndef ONE_LAUNCH
#define ONE_LAUNCH 1
#endif
#define DI __device__ __forceinline__
#define LAS __attribute__((address_space(3)))
using pg8::bf16_t; using pg8::bf16x8; using pg8::f32x4; using pg8::u32x4; using pg8::cvt_pk_bf16;
typedef unsigned u32x2 __attribute__((ext_vector_type(2)));
typedef short s16x4 __attribute__((ext_vector_type(4)));

constexpr int MP = 16384, MS = 512, M = MP + MS, D = 1024, NIN = 3328, NINSRC = 3080, DFF = 2816, NGU = 5632;
constexpr int NUNIT = 1024 + 128;
constexpr int NPH = 54, PPL = 13;
constexpr float EPS = 1e-6f;
constexpr size_t O_GDN_P = (size_t)M * D, O_CONV_P = O_GDN_P + 262144, O_GDN_S = O_CONV_P + 18432, O_CONV_S = O_GDN_S + 8388608, O_V_S = O_CONV_S + 589824, O_END = O_V_S + 1048576;
constexpr size_t WS_XB = 0, WS_MIX = WS_XB + (size_t)M * D * 2, WS_SSQ = WS_MIX + (size_t)M * D * 2, WS_BRAW = WS_SSQ + (size_t)M * 64, WS_GL = WS_BRAW + (size_t)M * 32,
    WS_WSP = WS_GL + 8192, WS_WSS = WS_WSP + 524288, WS_WIN = WS_WSS + 524288, WS_WO = WS_WIN + (size_t)NIN * D * 2, WS_WGU = WS_WO + (size_t)D * D * 2,
    WS_WD = WS_WGU + (size_t)NGU * D * 2, WS_Z = WS_WD + (size_t)D * DFF * 2, WS_QKV = WS_Z + (size_t)M * 512 * 2, WS_P = WS_QKV + (size_t)M * 1536 * 2,
    WS_Q = WS_P + (size_t)NUNIT * 32768, WS_R = WS_Q + (size_t)NUNIT * 32768, WS_O0 = WS_R + (size_t)NUNIT * 16384, WS_TSEG = WS_O0 + (size_t)NUNIT * 16384, WS_BSEG = WS_TSEG + 64 * 32768, WS_SSEG = WS_BSEG + 64 * 32768, WS_BAR = WS_SSEG + 64 * 65536, WS_END = WS_BAR + 16384;
constexpr size_t WS_ST = WS_QKV;
constexpr size_t WS_ACT = WS_Z;
static_assert((size_t)NUNIT * 32768 <= (size_t)M * 1536 * 2 && WS_ACT + (size_t)M * DFF * 2 <= WS_Q, "overlays");
constexpr int LDS_BYTES = 139264, L_MISC = 131072;

struct Params { const float* in[19]; float* out; unsigned char* ws; int lo, hi; };
enum { I_XP = 0, I_XS, I_SGDN, I_SCONV, I_WIN, I_CONVW, I_ALOG, I_DTB, I_GDNN, I_GWS, I_GBS, I_GNORM, I_WO, I_N1, I_N2, I_WG, I_WU, I_WD, I_FN };

DI float bf2f(unsigned short b) { return __uint_as_float((unsigned)b << 16); }
DI float bflo(unsigned w) { return __uint_as_float(w << 16); }
DI float bfhi(unsigned w) { return __uint_as_float(w & 0xffff0000u); }
DI unsigned short f2bf1(float f) { return (unsigned short)(cvt_pk_bf16(f, 0.f) & 0xffffu); }
DI float silu_f(float x) { return x * __builtin_amdgcn_rcpf(1.f + __expf(-x)); }
DI float sigmoid_f(float x) { return __builtin_amdgcn_rcpf(1.f + __expf(-x)); }
DI float softplus_f(float x) { const float t = __expf(-fabsf(x)); return fmaxf(x, 0.f) + (t < 1e-3f ? t * (1.f - 0.5f * t) : __logf(1.f + t)); }
DI float gelu_f(float x) { const float y = 0.7978845608028654f * (x + 0.044715f * x * x * x); const float e = __expf(2.f * y); return x * (1.f - __builtin_amdgcn_rcpf(e + 1.f)); }
DI float wave_sum(float v) {
#pragma unroll
    for (int o = 1; o < 64; o <<= 1) v += __shfl_xor(v, o);
    return v;
}
DI float rowscale(const float* ssq, int row) {
    const f32x4* s = (const f32x4*)(ssq + (size_t)row * 16); const f32x4 a = s[0], b = s[1], c = s[2], d = s[3];
    const float t = (((a.x + a.y) + (a.z + a.w)) + ((b.x + b.y) + (b.z + b.w))) + (((c.x + c.y) + (c.z + c.w)) + ((d.x + d.y) + (d.z + d.w)));
    return rsqrtf(t * (1.f / 1024.f) + EPS);
}
DI float rowscale4(const float* ssq, int row, int fq) {
    const f32x4 a = ((const f32x4*)(ssq + (size_t)row * 16))[fq]; float t = (a.x + a.y) + (a.z + a.w);
    t += __shfl_xor(t, 16); t += __shfl_xor(t, 32);
    return rsqrtf(t * (1.f / 1024.f) + EPS);
}
DI u32x4 pack8(const f32x4 a, const f32x4 b) { u32x4 w; w.x = cvt_pk_bf16(a[0], a[1]); w.y = cvt_pk_bf16(a[2], a[3]); w.z = cvt_pk_bf16(b[0], b[1]); w.w = cvt_pk_bf16(b[2], b[3]); return w; }
DI u32x2 pack4(const f32x4 a) { u32x2 w; w.x = cvt_pk_bf16(a[0], a[1]); w.y = cvt_pk_bf16(a[2], a[3]); return w; }
#define MFMA16(a, b, c) __builtin_amdgcn_mfma_f32_16x16x32_bf16((a), (b), (c), 0, 0, 0)
typedef short v4i16_t __attribute__((ext_vector_type(4)));
DI bf16x8 tr_frag(const LAS unsigned char* img, int pitch, int k0, int col0, int lane) {
    const int l16 = lane & 15, q = l16 >> 2, pp = l16 & 3, fq = lane >> 4;
    const LAS unsigned char* a0 = img + (k0 + 8 * fq + q) * pitch + (col0 + 4 * pp) * 2;
    const v4i16_t lo = __builtin_amdgcn_ds_read_tr16_b64_v4i16((LAS v4i16_t*)a0);
    const v4i16_t hi = __builtin_amdgcn_ds_read_tr16_b64_v4i16((LAS v4i16_t*)(a0 + 4 * pitch));
    return __builtin_shufflevector(lo, hi, 0, 1, 2, 3, 4, 5, 6, 7);
}

DI void transpose_item(const float* W, int ldn, int k0, int nsrc0, int nvalid, bf16_t* WT, int K, int ndst0, const float* gs, LAS float* scr, int lane) {
    { const int n = lane & 31; const bool ok = nsrc0 + n < nvalid; const float* wp = W + (size_t)(k0 + (lane >> 5)) * ldn + (ok ? nsrc0 + n : 0);
      float v[32];
#pragma unroll
      for (int i = 0; i < 32; ++i) v[i] = ok ? __builtin_nontemporal_load(&wp[(size_t)(2 * i) * ldn]) : 0.f;
      if (gs) {
#pragma unroll
          for (int i = 0; i < 32; ++i) v[i] *= gs[k0 + 2 * i + (lane >> 5)]; }
#pragma unroll
      for (int i = 0; i < 32; ++i) scr[(2 * i + (lane >> 5)) * 33 + n] = v[i]; }
    asm volatile("s_waitcnt lgkmcnt(0)" ::: "memory");
    const int c = lane & 7;
#pragma unroll
    for (int j = 0; j < 4; ++j) { const int n = (lane >> 3) + 8 * j; const LAS float* s = scr + (8 * c) * 33 + n;
        u32x4 o; o.x = cvt_pk_bf16(s[0 * 33], s[1 * 33]); o.y = cvt_pk_bf16(s[2 * 33], s[3 * 33]); o.z = cvt_pk_bf16(s[4 * 33], s[5 * 33]); o.w = cvt_pk_bf16(s[6 * 33], s[7 * 33]);
        *(u32x4*)(WT + (size_t)(ndst0 + n) * K + k0 + 8 * c) = o; }
    asm volatile("s_waitcnt lgkmcnt(0)" ::: "memory");
}
DI void conv_win(const Params& p, int l, int it, LAS float* scr, int lane) {
    const int kb = it / 104, nb = it % 104, nd = 32 * nb; int ns, nvalid = NINSRC;
    if (nd < 1024) { const int g = nd >> 8, r = nd & 255, bj = r >> 7, c = r & 127; ns = bj * 512 + g * 128 + c; }
    else if (nd <= 3072) ns = nd;
    else { ns = 0; nvalid = 0; }
    transpose_item(p.in[I_WIN] + (size_t)l * D * NINSRC, NINSRC, 64 * kb, ns, nvalid, (bf16_t*)(p.ws + WS_WIN), D, nd, p.in[I_N1] + l * D, scr, lane);
}
DI void conv_wo(const Params& p, int l, int it, LAS float* scr, int lane) {
    const int kb = it >> 5, nb = it & 31;
    transpose_item(p.in[I_WO] + (size_t)l * D * D, D, 64 * kb, 32 * nb, D, (bf16_t*)(p.ws + WS_WO), D, 32 * nb, nullptr, scr, lane);
}
DI void conv_wgu(const Params& p, int l, int it, LAS float* scr, int lane) {
    const int kb = it / 176, nb = it % 176, nd = 32 * nb, t = nd >> 8, r = nd & 255, bj = r >> 7, c = r & 127;
    const float* W = (bj ? p.in[I_WU] : p.in[I_WG]) + (size_t)l * D * DFF;
    transpose_item(W, DFF, 64 * kb, 128 * t + c, DFF, (bf16_t*)(p.ws + WS_WGU), D, nd, p.in[I_N2] + l * D, scr, lane);
}
DI void conv_wd(const Params& p, int l, int it, LAS float* scr, int lane) {
    const int kb = it >> 5, nb = it & 31;
    transpose_item(p.in[I_WD] + (size_t)l * DFF * D, D, 64 * kb, 32 * nb, D, (bf16_t*)(p.ws + WS_WD), DFF, 32 * nb, nullptr, scr, lane);
}
DI void convert_wg_item(const Params& p, int l, int j, LAS unsigned char* lds, int lane, int wave) {
    __syncthreads();
    LAS float* scr = (LAS float*)(lds + wave * 16384);
    int w = 8 * j + wave;
    if (w < 512) { conv_wo(p, l, w, scr, lane); return; } w -= 512;
    if (w < 2816) { conv_wgu(p, l, w, scr, lane); return; } w -= 2816;
    if (w < 1408) { conv_wd(p, l, w, scr, lane); return; } w -= 1408;
    if (l < 3 && w < 1664) conv_win(p, l + 1, w, scr, lane);
}

DI void phase0(const Params& p, LAS unsigned char* lds, int tid, int lane, int wave, int G) {
    const int gw = blockIdx.x * 8 + wave, NGW = G * 8;
    LAS float* scr = (LAS float*)(lds + wave * 16384);
    for (int it = gw; it < 1664; it += NGW) conv_win(p, 0, it, scr, lane);
    float* X = p.out; bf16_t* xb = (bf16_t*)(p.ws + WS_XB); float* ssq = (float*)(p.ws + WS_SSQ);
    for (int m = gw; m < M; m += NGW) {
        const float* src = m < MP ? p.in[I_XP] + (size_t)m * D : p.in[I_XS] + (size_t)(m - MP) * D;
        f32x4 v[4]; float s = 0.f;
#pragma unroll
        for (int j = 0; j < 4; ++j) { v[j] = __builtin_nontemporal_load(&((const f32x4*)src)[lane + 64 * j]); s += (v[j].x * v[j].x + v[j].y * v[j].y) + (v[j].z * v[j].z + v[j].w * v[j].w); }
        s = wave_sum(s);
#pragma unroll
        for (int j = 0; j < 4; ++j) { ((f32x4*)(X + (size_t)m * D))[lane + 64 * j] = v[j]; ((u32x2*)(xb + (size_t)m * D))[lane + 64 * j] = pack4(v[j]); }
        if (lane < 16) ssq[(size_t)m * 16 + lane] = lane == 0 ? s : 0.f;
    }
    bf16_t* wsp = (bf16_t*)(p.ws + WS_WSP); bf16_t* wss = (bf16_t*)(p.ws + WS_WSS); const float* gws = p.in[I_GWS];
    for (int e = blockIdx.x * 512 + tid; e < 16 * 16384; e += G * 512) {
        const int lg = e >> 14, i = (e >> 7) & 127, j = e & 127;
        wsp[e] = ((j >> 6) <= (i >> 6)) ? f2bf1(gws[e]) : (unsigned short)0;
        wss[e] = ((i >> 4) == (j >> 4)) ? f2bf1(gws[(size_t)lg * 16384 + (i & 15) * 128 + (j & 15)]) : (unsigned short)0;
    }
}

struct EpiIn {
    static constexpr bool PERM = true, AFTER_DRAIN = false;
    const float* ssq; bf16_t* mix; bf16_t* qkv; bf16_t* z; float* braw; float* convp; float* convs; float* vs;
    DI void operator()(const f32x4 (&acc)[2][2][4][2], const pg8::Unit& u, int wr, int wc, int fr, int fq) const {
        const int pn = u.pn;
        float rsv[2][4];
#pragma unroll
        for (int ai = 0; ai < 2; ++ai)
#pragma unroll
            for (int m = 0; m < 4; ++m) rsv[ai][m] = rowscale4(ssq, u.pm * 256 + ai * 128 + wr * 64 + m * 16 + fr, fq);
#pragma unroll
        for (int ai = 0; ai < 2; ++ai)
#pragma unroll
            for (int m = 0; m < 4; ++m) {
                const int row = u.pm * 256 + ai * 128 + wr * 64 + m * 16 + fr; const float rs = rsv[ai][m];
                if (pn < 4) {
#pragma unroll
                    for (int bj = 0; bj < 2; ++bj) { f32x4 v0 = acc[ai][bj][m][0] * rs, v1 = acc[ai][bj][m][1] * rs;
#pragma unroll
                        for (int e = 0; e < 4; ++e) { v0[e] = gelu_f(v0[e]); v1[e] = gelu_f(v1[e]); }
                        const int col = pn * 128 + wc * 32 + 8 * fq;
                        *(u32x4*)(mix + (size_t)row * 1024 + bj * 512 + col) = pack8(v0, v1);
                        if (bj == 1 && row >= MP) { float* o = vs + (size_t)(row - MP) * 512 + col; *(f32x4*)o = v0; *(f32x4*)(o + 4) = v1; } }
                } else if (pn < 10) {
#pragma unroll
                    for (int bj = 0; bj < 2; ++bj) { const f32x4 v0 = acc[ai][bj][m][0] * rs, v1 = acc[ai][bj][m][1] * rs;
                        const int j0 = (pn - 4) * 256 + bj * 128 + wc * 32 + 8 * fq;
                        *(u32x4*)(qkv + (size_t)row * 1536 + j0) = pack8(v0, v1);
                        float* cb = nullptr;
                        if (row >= MP) { const int t = (row - MP) & 15; if (t >= 13) cb = convs + ((size_t)((row - MP) >> 4) * 3 + (t - 13)) * 1536 + j0; }
                        else if (row >= MP - 3) cb = convp + (size_t)(row - (MP - 3)) * 1536 + j0;
                        if (cb) { *(f32x4*)cb = v0; *(f32x4*)(cb + 4) = v1; } }
                } else if (pn < 12) {
#pragma unroll
                    for (int bj = 0; bj < 2; ++bj) { const f32x4 v0 = acc[ai][bj][m][0] * rs, v1 = acc[ai][bj][m][1] * rs;
                        *(u32x4*)(z + (size_t)row * 512 + (pn - 10) * 256 + bj * 128 + wc * 32 + 8 * fq) = pack8(v0, v1); }
                } else {
                    if (wc == 0 && fq == 0) { float* o = braw + (size_t)row * 8; *(f32x4*)o = acc[ai][0][m][0] * rs; *(f32x4*)(o + 4) = acc[ai][0][m][1] * rs; }
                }
            }
    }
};
struct EpiRes {
    static constexpr bool PERM = true, AFTER_DRAIN = false;
    float* X; bf16_t* xb; float* ssq;
    DI void operator()(const f32x4 (&acc)[2][2][4][2], const pg8::Unit& u, int wr, int wc, int fr, int fq) const {
        const int rowb = u.pm * 256 + wr * 64 + fr, colb = u.pn * 256 + wc * 32 + 8 * fq;
        f32x4 cur[4], nxt[4];
        { const float* xp = X + (size_t)rowb * D + colb; cur[0] = *(const f32x4*)xp; cur[1] = *(const f32x4*)(xp + 4); cur[2] = *(const f32x4*)(xp + 128); cur[3] = *(const f32x4*)(xp + 132); }
#pragma unroll
        for (int q = 0; q < 8; ++q) { const int ai = q >> 2, m = q & 3;
            const int row = rowb + ai * 128 + m * 16; float part = 0.f;
            if (q < 7) { const int q1 = q + 1; const float* xp = X + (size_t)(rowb + (q1 >> 2) * 128 + (q1 & 3) * 16) * D + colb; nxt[0] = *(const f32x4*)xp; nxt[1] = *(const f32x4*)(xp + 4); nxt[2] = *(const f32x4*)(xp + 128); nxt[3] = *(const f32x4*)(xp + 132); }
#pragma unroll
            for (int bj = 0; bj < 2; ++bj) { const int col = colb + bj * 128; float* xp = X + (size_t)row * D + col;
                const f32x4 a = cur[2 * bj] + acc[ai][bj][m][0], b = cur[2 * bj + 1] + acc[ai][bj][m][1];
                *(f32x4*)xp = a; *(f32x4*)(xp + 4) = b; *(u32x4*)(xb + (size_t)row * D + col) = pack8(a, b);
                part += ((a.x * a.x + a.y * a.y) + (a.z * a.z + a.w * a.w)) + ((b.x * b.x + b.y * b.y) + (b.z * b.z + b.w * b.w)); }
            part += __shfl_xor(part, 16); part += __shfl_xor(part, 32);
            if (fq == 0) ssq[(size_t)row * 16 + u.pn * 4 + wc] = part;
#pragma unroll
            for (int e = 0; e < 4; ++e) cur[e] = nxt[e];
        }
    }
};
struct EpiGU {
    static constexpr bool PERM = true, AFTER_DRAIN = false;
    const float* ssq; bf16_t* act;
    DI void operator()(const f32x4 (&acc)[2][2][4][2], const pg8::Unit& u, int wr, int wc, int fr, int fq) const {
        float rsv[2][4];
#pragma unroll
        for (int ai = 0; ai < 2; ++ai)
#pragma unroll
            for (int m = 0; m < 4; ++m) rsv[ai][m] = rowscale4(ssq, u.pm * 256 + ai * 128 + wr * 64 + m * 16 + fr, fq);
#pragma unroll
        for (int ai = 0; ai < 2; ++ai)
#pragma unroll
            for (int m = 0; m < 4; ++m) {
                const int row = u.pm * 256 + ai * 128 + wr * 64 + m * 16 + fr; const float rs = rsv[ai][m];
                f32x4 o[2];
#pragma unroll
                for (int n = 0; n < 2; ++n) { const f32x4 g = acc[ai][0][m][n] * rs, up = acc[ai][1][m][n] * rs;
#pragma unroll
                    for (int e = 0; e < 4; ++e) o[n][e] = silu_f(g[e]) * up[e]; }
                *(u32x4*)(act + (size_t)row * DFF + u.pn * 128 + wc * 32 + 8 * fq) = pack8(o[0], o[1]);
            }
    }
};

struct PieceOrder {
    int c, nslice;
    DI bool next(int i, pg8::Unit& u) const { if (i > 0 || c >= 8 * nslice) return false; const int su = c / nslice, ks = c - su * nslice; u.pm = 64 + (su >> 2); u.pn = su & 3; u.koff = ks * 256; return true; }
    DI void a_ready(const pg8::Unit&) const {}
    DI void done(const pg8::Unit&) const {}
};
struct EpiPart {
    static constexpr bool PERM = true, AFTER_DRAIN = false;
    float* part;
    DI void operator()(const f32x4 (&acc)[2][2][4][2], const pg8::Unit& u, int wr, int wc, int fr, int fq) const {
        float* base = part + (size_t)(u.koff >> 8) * 512 * 1024;
#pragma unroll
        for (int ai = 0; ai < 2; ++ai)
#pragma unroll
            for (int m = 0; m < 4; ++m) { const int row = (u.pm - 64) * 256 + ai * 128 + wr * 64 + m * 16 + fr;
#pragma unroll
                for (int bj = 0; bj < 2; ++bj) { float* o = base + (size_t)row * 1024 + u.pn * 256 + bj * 128 + wc * 32 + 8 * fq; *(f32x4*)o = acc[ai][bj][m][0]; *(f32x4*)(o + 4) = acc[ai][bj][m][1]; } }
    }
};
struct MixOrder {
    pg8::StaticOrder so; int c, nslice; bool piece;
    DI bool next(int i, pg8::Unit& u) const {
        if (!piece) return so.next(i, u);
        if (i > 0 || c >= 8 * nslice) return false; const int su = c / nslice, ks = c - su * nslice; u.pm = 64 + (su >> 2); u.pn = su & 3; u.koff = ks * 256; return true; }
    DI void a_ready(const pg8::Unit&) const {}
    DI void done(const pg8::Unit&) const {}
};
struct EpiRes2 {
    static constexpr bool PERM = true, AFTER_DRAIN = false;
    float* X; bf16_t* xb; float* ssq; float* part; bool piece;
    DI void operator()(const f32x4 (&acc)[2][2][4][2], const pg8::Unit& u, int wr, int wc, int fr, int fq) const {
        if (piece) { EpiPart e{part}; e(acc, u, wr, wc, fr, fq); } else { EpiRes e{X, xb, ssq}; e(acc, u, wr, wc, fr, fq); }
    }
};
DI void sample_finalize(const Params& p, int nslice, int lane, int wave, int G) {
    float* X = p.out; bf16_t* xb = (bf16_t*)(p.ws + WS_XB); float* ssq = (float*)(p.ws + WS_SSQ); const float* part = (const float*)(p.ws + WS_Q);
    for (int wt = blockIdx.x * 8 + wave; wt < MS * 4; wt += G * 8) {
        const int rs = wt >> 2, j = wt & 3, m = MP + rs;
        f32x4 v = ((const f32x4*)(X + (size_t)m * D))[lane + 64 * j];
        f32x4 pv[11];
#pragma unroll
        for (int k = 0; k < 11; ++k) pv[k] = ((const f32x4*)(part + ((size_t)(k < nslice ? k : 0) * 512 + rs) * 1024))[lane + 64 * j];
#pragma unroll
        for (int k = 0; k < 11; ++k) if (k < nslice) v += pv[k];
        const float s = wave_sum((v.x * v.x + v.y * v.y) + (v.z * v.z + v.w * v.w));
        ((f32x4*)(X + (size_t)m * D))[lane + 64 * j] = v; ((u32x2*)(xb + (size_t)m * D))[lane + 64 * j] = pack4(v);
        if (lane < 4) ssq[(size_t)m * 16 + j + 4 * lane] = lane == 0 ? s : 0.f;
    }
}

DI int afrag_off(int r, int k) { return (((r >> 4) * 4 + (k >> 5)) * 64 + ((k & 31) >> 3) * 16 + (r & 15)) * 8 + (k & 7); }
DI int cfrag_off(int n, int a) { return (((n >> 4) * 8 + (a >> 4)) * 64 + ((a & 15) >> 2) * 16 + (n & 15)) * 4 + (a & 3); }
constexpr int PB = 272;
constexpr int L_QS = 0, L_KS = 17408, L_VS = 34816, L_US = 52224, L_WS = 69632, L_MM = 87040, L_AT = 104448, L_PART = 113664, L_BETA = 125952, L_BCUM = L_BETA + 256, L_EBC = L_BCUM + 256, L_SCL = L_EBC + 256;
static_assert(L_SCL + 512 <= L_MISC, "prep LDS");

DI int ustore(int u) { return u < 1024 ? (u & 3) * 256 + (u >> 2) : u; }
DI void unit_geom(int u, bool& isS, int& h, int& row0, int& Lv, int& b, int& c) {
    isS = u >= 1024; h = u & 3;
    if (!isS) { c = u >> 2; b = 0; row0 = 64 * c; Lv = 64; } else { b = (u - 1024) >> 2; c = 0; row0 = MP + 16 * b; Lv = 16; }
}
template <int MODE = 0> DI void prep_unit(const Params& p, int l, int u, LAS unsigned char* lds, int tid_in, int lane_in, int wave) {
    bool isS; int h, row0, Lv, b, c; unit_geom(u, isS, h, row0, Lv, b, c);
    int tid_ = tid_in; asm volatile("" : "+v"(tid_));
    const int tid = tid_, lane = tid & 63; (void)lane_in;
    const int fr = lane & 15, fq = lane >> 4;
    const bf16_t* qkv = (const bf16_t*)(p.ws + WS_QKV);
    LAS float* PART = (LAS float*)(lds + L_PART); LAS float* BETA = (LAS float*)(lds + L_BETA); LAS float* BCUM = (LAS float*)(lds + L_BCUM);
    LAS float* EBC = (LAS float*)(lds + L_EBC); LAS float* SCL = (LAS float*)(lds + L_SCL); LAS float* MM = (LAS float*)(lds + L_MM);
    __syncthreads();
    const int cgp = tid % 48, rseg = tid / 48, which = cgp >> 4, c8 = (cgp & 15) * 8, col = which * 512 + h * 128 + c8;
    const bool actv = tid < 384;
    if (actv) {
        float w[4][8];
        const float* cw = p.in[I_CONVW] + (size_t)l * 4 * 1536 + col;
#pragma unroll
        for (int i = 0; i < 4; ++i) { const f32x4 a = *(const f32x4*)(cw + i * 1536), bb = *(const f32x4*)(cw + i * 1536 + 4);
#pragma unroll
            for (int e = 0; e < 4; ++e) { w[i][e] = a[e]; w[i][4 + e] = bb[e]; } }
        float hx[3][8]; u32x4 raw[11];
#pragma unroll
        for (int j = 0; j < 11; ++j) { int rowi = row0 + 8 * rseg - 3 + j; rowi = rowi < 0 ? 0 : (rowi > M - 1 ? M - 1 : rowi); raw[j] = *(const u32x4*)(qkv + (size_t)rowi * 1536 + col); }
#pragma unroll
        for (int j = 0; j < 3; ++j) { const int tt = 8 * rseg - 3 + j; const bool valid = tt >= 0 ? (tt < Lv) : (!isS && c > 0); const u32x4 r = raw[j];
            hx[j][0] = valid ? bflo(r.x) : 0.f; hx[j][1] = valid ? bfhi(r.x) : 0.f; hx[j][2] = valid ? bflo(r.y) : 0.f; hx[j][3] = valid ? bfhi(r.y) : 0.f;
            hx[j][4] = valid ? bflo(r.z) : 0.f; hx[j][5] = valid ? bfhi(r.z) : 0.f; hx[j][6] = valid ? bflo(r.w) : 0.f; hx[j][7] = valid ? bfhi(r.w) : 0.f; }
        if (isS && rseg == 0) {
#pragma unroll
            for (int j = 0; j < 3; ++j) { const float* sp = p.in[I_SCONV] + ((size_t)(l * 32 + b) * 3 + j) * 1536 + col; const f32x4 a = *(const f32x4*)sp, bb = *(const f32x4*)(sp + 4);
#pragma unroll
                for (int e = 0; e < 4; ++e) { hx[j][e] = a[e]; hx[j][4 + e] = bb[e]; } }
        }
#pragma unroll
        for (int r = 0; r < 8; ++r) { float cur[8]; { const bool valid = 8 * rseg + r < Lv; const u32x4 q = raw[3 + r];
                cur[0] = valid ? bflo(q.x) : 0.f; cur[1] = valid ? bfhi(q.x) : 0.f; cur[2] = valid ? bflo(q.y) : 0.f; cur[3] = valid ? bfhi(q.y) : 0.f;
                cur[4] = valid ? bflo(q.z) : 0.f; cur[5] = valid ? bfhi(q.z) : 0.f; cur[6] = valid ? bflo(q.w) : 0.f; cur[7] = valid ? bfhi(q.w) : 0.f; }
            float s = 0.f;
            float a[8];
#pragma unroll
            for (int e = 0; e < 8; ++e) { const float y = w[0][e] * hx[0][e] + w[1][e] * hx[1][e] + w[2][e] * hx[2][e] + w[3][e] * cur[e]; a[e] = (8 * rseg + r < Lv) ? silu_f(y) : 0.f; s += a[e] * a[e];
                hx[0][e] = hx[1][e]; hx[1][e] = hx[2][e]; hx[2][e] = cur[e]; }
            if (which < 2) PART[(8 * rseg + r) * 48 + cgp] = s;
            u32x4 o; o.x = cvt_pk_bf16(a[0], a[1]); o.y = cvt_pk_bf16(a[2], a[3]); o.z = cvt_pk_bf16(a[4], a[5]); o.w = cvt_pk_bf16(a[6], a[7]);
            *(LAS u32x4*)(lds + which * 17408 + (8 * rseg + r) * PB + c8 * 2) = o; }
    }
    if (tid < 64) {
        const int row = tid; float beta = 0.f, g = 0.f;
        if (row < Lv) { const float* br = (const float*)(p.ws + WS_BRAW) + (size_t)(row0 + row) * 8; beta = sigmoid_f(br[h]);
            g = -__expf(p.in[I_ALOG][l * 4 + h]) * softplus_f(br[4 + h] + p.in[I_DTB][l * 4 + h]); }
        float cs = g;
#pragma unroll
        for (int o = 1; o < 64; o <<= 1) { const float t = __shfl_up(cs, o); if (lane >= o) cs += t; }
        BETA[row] = beta; BCUM[row] = cs; EBC[row] = __expf(cs);
        const float bl = __shfl(cs, 63);
        if (lane == 0 && MODE == 0) ((float*)(p.ws + WS_GL))[ustore(u)] = __expf(bl);
    }
    __syncthreads();
    if (tid < 128) { const int row = tid >> 1, wh = tid & 1; float s = 0.f;
#pragma unroll
        for (int i = 0; i < 16; ++i) s += PART[row * 48 + wh * 16 + i];
        SCL[row * 2 + wh] = rsqrtf(s + EPS) * (wh == 0 ? 0.08838834764831845f : 1.f); }
    __syncthreads();
    {
        const int mat = wave >> 2, it = wave & 3; const LAS unsigned char* Ai = lds + (mat ? L_QS : L_KS);
        bf16x8 af[4];
#pragma unroll
        for (int s = 0; s < 4; ++s) af[s] = *(const LAS bf16x8*)(Ai + (16 * it + fr) * PB + (32 * s + 8 * fq) * 2);
        float rowf[4], bci[4];
#pragma unroll
        for (int r = 0; r < 4; ++r) { const int i = 16 * it + 4 * fq + r; bci[r] = BCUM[i]; rowf[r] = mat ? SCL[i * 2] : BETA[i] * SCL[i * 2 + 1]; }
#pragma unroll
        for (int jt = 0; jt < 4; ++jt) {
            const int j = 16 * jt + fr;
            if (jt > it) {
#pragma unroll
                for (int r = 0; r < 4; ++r) { const int i = 16 * it + 4 * fq + r;
                    if (mat == 0) { MM[i * 68 + j] = 0.f; *(LAS unsigned short*)(lds + L_PART + i * 144 + j * 2) = (unsigned short)0; }
                    else *(LAS unsigned short*)(lds + L_AT + i * 144 + j * 2) = (unsigned short)0; }
                continue;
            }
            f32x4 acc = {0.f, 0.f, 0.f, 0.f};
#pragma unroll
            for (int s = 0; s < 4; ++s) { const bf16x8 bf = *(const LAS bf16x8*)(lds + L_KS + (16 * jt + fr) * PB + (32 * s + 8 * fq) * 2); acc = MFMA16(af[s], bf, acc); }
            const float bcj = BCUM[j], skj = SCL[j * 2 + 1];
#pragma unroll
            for (int r = 0; r < 4; ++r) { const int i = 16 * it + 4 * fq + r; const float dec = (i >= j) ? __expf(bci[r] - bcj) : 0.f; const float v = acc[r] * skj * rowf[r] * dec;
                if (mat == 0) { const float mv = (i > j) ? v : 0.f; MM[i * 68 + j] = mv; *(LAS unsigned short*)(lds + L_PART + i * 144 + j * 2) = (it == jt) ? (unsigned short)0 : f2bf1(mv); }
                else *(LAS unsigned short*)(lds + L_AT + i * 144 + j * 2) = f2bf1(v); }
        }
    }
    __syncthreads();
    LAS unsigned char* DB = lds + L_MISC + 2048;
    if (MODE != 1 && wave < 4) {
        const int b = wave; f32x4 y;
#pragma unroll
        for (int r = 0; r < 4; ++r) y[r] = (4 * fq + r == fr) ? 1.f : 0.f;
#pragma unroll
        for (int g = 0; g < 4; ++g) {
            f32x4 mg[4];
#pragma unroll
            for (int r = 0; r < 4; ++r) mg[r] = *(const LAS f32x4*)(MM + (16 * b + 4 * fq + r) * 68 + 16 * b + 4 * g);
            f32x4 xl; xl[0] = y[0]; xl[1] = y[1] - mg[1][0] * xl[0]; xl[2] = y[2] - mg[2][0] * xl[0] - mg[2][1] * xl[1]; xl[3] = y[3] - mg[3][0] * xl[0] - mg[3][1] * xl[1] - mg[3][2] * xl[2];
            f32x4 xg;
#pragma unroll
            for (int r = 0; r < 4; ++r) xg[r] = __shfl(xl[r], fr + 16 * g);
#pragma unroll
            for (int r = 0; r < 4; ++r) { const float upd = y[r] - (mg[r][0] * xg[0] + mg[r][1] * xg[1] + mg[r][2] * xg[2] + mg[r][3] * xg[3]); y[r] = fq > g ? upd : (fq == g ? xl[r] : y[r]); }
        }
#pragma unroll
        for (int r = 0; r < 4; ++r) { LAS unsigned char* rowp = DB + b * 1280 + (4 * fq + r) * 80; *(LAS unsigned short*)(rowp + (16 * (b & 1) + fr) * 2) = f2bf1(y[r]); *(LAS unsigned short*)(rowp + (16 * (1 - (b & 1)) + fr) * 2) = (unsigned short)0; }
    }
    __syncthreads();
    if (MODE != 1) {
        const LAS unsigned char* MB = lds + L_PART; const f32x4 zero4 = {0.f, 0.f, 0.f, 0.f};
#pragma unroll 1
        for (int cti = 0; cti < 2; ++cti) {
            const int ct = 2 * wave + cti, isw = ct >> 3, c0 = (ct & 7) * 16;
            const LAS unsigned char* src = lds + (isw ? L_KS : L_VS); LAS unsigned char* dst = lds + (isw ? L_WS : L_US);
            { const u32x4 z = {0u, 0u, 0u, 0u}; *(LAS u32x4*)(dst + lane * PB + c0 * 2) = z; *(LAS u32x4*)(dst + lane * PB + c0 * 2 + 16) = z; }
#pragma unroll
            for (int b = 0; b < 4; ++b) {
                if (b > 0 && isS) break;
                f32x4 y;
#pragma unroll
                for (int r = 0; r < 4; ++r) { const int i = 16 * b + 4 * fq + r; float v = bf2f(*(const LAS unsigned short*)(src + i * PB + (c0 + fr) * 2)) * BETA[i]; if (isw) v *= EBC[i] * SCL[i * 2 + 1]; y[r] = v; }
                if (b > 0) {
                    f32x4 t = MFMA16(*(const LAS bf16x8*)(MB + (16 * b + fr) * 144 + 16 * fq), tr_frag(dst, PB, 0, c0, lane), zero4);
                    if (b == 3) t = MFMA16(*(const LAS bf16x8*)(MB + (16 * b + fr) * 144 + 64 + 16 * fq), tr_frag(dst, PB, 32, c0, lane), t);
                    y = y - t;
                }
                LAS unsigned char* xp = dst + (16 * b + 4 * fq) * PB + (c0 + fr) * 2;
#pragma unroll
                for (int r = 0; r < 4; ++r) *(LAS unsigned short*)(xp + r * PB) = f2bf1(y[r]);
                const f32x4 x = MFMA16(*(const LAS bf16x8*)(DB + b * 1280 + fr * 80 + 16 * fq), tr_frag(dst, PB, 32 * (b >> 1), c0, lane), zero4);
#pragma unroll
                for (int r = 0; r < 4; ++r) *(LAS unsigned short*)(xp + r * PB) = f2bf1(x[r]);
            }
        }
    }
    __syncthreads();
    if (MODE == 2) return;
    { const int i = tid >> 3, seg = tid & 7; const float f = __expf(BCUM[63] - BCUM[i]) * SCL[i * 2 + 1]; LAS u32x4* kp = (LAS u32x4*)(lds + L_KS + i * PB + seg * 32);
#pragma unroll
        for (int q = 0; q < 2; ++q) { u32x4 r = kp[q]; r.x = cvt_pk_bf16(bflo(r.x) * f, bfhi(r.x) * f); r.y = cvt_pk_bf16(bflo(r.y) * f, bfhi(r.y) * f); r.z = cvt_pk_bf16(bflo(r.z) * f, bfhi(r.z) * f); r.w = cvt_pk_bf16(bflo(r.w) * f, bfhi(r.w) * f); kp[q] = r; } }
    __syncthreads();
    {
        int lane_ = lane; asm volatile("" : "+v"(lane_));
        const int lane = lane_, fr = lane & 15, fq = lane >> 4;
        const int us = ustore(u);
        bf16_t* Pg = (bf16_t*)(p.ws + WS_P) + (size_t)us * 16384; bf16_t* Qg = (bf16_t*)(p.ws + WS_Q) + (size_t)us * 16384;
        bf16_t* Rg = (bf16_t*)(p.ws + WS_R) + (size_t)us * 8192; bf16_t* Og = (bf16_t*)(p.ws + WS_O0) + (size_t)us * 8192;
        const f32x4 zero = {0.f, 0.f, 0.f, 0.f};
        bf16x8 y0, y1;
        y0 = tr_frag(lds + L_KS, PB, 0, 16 * wave, lane); y1 = tr_frag(lds + L_KS, PB, 32, 16 * wave, lane);
#pragma unroll
        for (int it = 0; it < 8; ++it) { const bf16x8 x0 = tr_frag(lds + L_WS, PB, 0, 16 * it, lane), x1 = tr_frag(lds + L_WS, PB, 32, 16 * it, lane);
            f32x4 a = MFMA16(x0, y0, zero); a = MFMA16(x1, y1, a); a = -a;
            if (MODE == 0 || a[0] == 123.456f) *(u32x2*)(Pg + afrag_off(16 * wave + fr, 16 * it + 4 * fq)) = pack4(a); }
        y0 = tr_frag(lds + L_US, PB, 0, 16 * wave, lane); y1 = tr_frag(lds + L_US, PB, 32, 16 * wave, lane);
#pragma unroll
        for (int it = 0; it < 8; ++it) { const bf16x8 x0 = tr_frag(lds + L_KS, PB, 0, 16 * it, lane), x1 = tr_frag(lds + L_KS, PB, 32, 16 * it, lane);
            f32x4 a = MFMA16(x0, y0, zero); a = MFMA16(x1, y1, a);
            if (MODE == 0 || a[0] == 123.456f) *(u32x2*)(Qg + cfrag_off(16 * wave + fr, 16 * it + 4 * fq)) = pack4(a); }
        const int t0 = 16 * (wave & 3), ib = (wave >> 2) * 4; const int t = t0 + fr;
        y0 = *(const LAS bf16x8*)(lds + L_AT + t * 144 + (8 * fq) * 2); y1 = *(const LAS bf16x8*)(lds + L_AT + t * 144 + (32 + 8 * fq) * 2);
        const float eb = EBC[t] * SCL[t * 2];
#pragma unroll
        for (int q = 0; q < 4; ++q) { const int it = ib + q; const bf16x8 x0 = tr_frag(lds + L_WS, PB, 0, 16 * it, lane), x1 = tr_frag(lds + L_WS, PB, 32, 16 * it, lane);
            f32x4 a = MFMA16(x0, y0, zero); a = MFMA16(x1, y1, a);
            const u32x2 qv = *(const LAS u32x2*)(lds + L_QS + t * PB + (16 * it + 4 * fq) * 2);
            f32x4 rr; rr[0] = bflo(qv.x) * eb - a[0]; rr[1] = bfhi(qv.x) * eb - a[1]; rr[2] = bflo(qv.y) * eb - a[2]; rr[3] = bfhi(qv.y) * eb - a[3];
            if (MODE == 0 || rr[0] == 123.456f) *(u32x2*)(Rg + afrag_off(t, 16 * it + 4 * fq)) = pack4(rr); }
#pragma unroll
        for (int q = 0; q < 4; ++q) { const int it = ib + q; const bf16x8 x0 = tr_frag(lds + L_US, PB, 0, 16 * it, lane), x1 = tr_frag(lds + L_US, PB, 32, 16 * it, lane);
            f32x4 a = MFMA16(x0, y0, zero); a = MFMA16(x1, y1, a);
            if (MODE == 0 || a[0] == 123.456f) *(u32x2*)(Og + cfrag_off(t, 16 * it + 4 * fq)) = pack4(a); }
    }
}

struct ScanArgs {
    const bf16_t* P; const bf16_t* Q; const float* G;
    int nsteps, init;
    const float* Sinit;
    bf16_t* St;
    float* Sstep;
    float* Fout; bf16_t* Trow; bf16_t* Tcol;
    int n0;
};
template <int NT> DI void scan_run(const ScanArgs& A, LAS unsigned char* lds, int lane, int wave) {
    const int fr = lane & 15, fq = lane >> 4, a0 = 16 * wave;
    int zo; asm volatile("v_mov_b32 %0, 0" : "=v"(zo));
    const float* GL = A.G ? A.G + zo : nullptr;
    const bf16_t* Pg = A.P + afrag_off(a0 + fr, 8 * fq);
    const int qoff = cfrag_off(A.n0 + fr, a0 + 4 * fq);
    const int roff = (a0 + 4 * fq) * 128 + A.n0 + fr;
    constexpr int IMG = 16 * NT * PB;
    const int wofs = fr * PB + (a0 + 4 * fq) * 2, rofs = fr * PB + 16 * fq;
    const int nsteps = A.nsteps;
    f32x4 S[NT];
#pragma unroll
    for (int t = 0; t < NT; ++t)
#pragma unroll
        for (int r = 0; r < 4; ++r) S[t][r] = A.init == 2 ? A.Sinit[roff + 16 * t + r * 128] : (A.init == 1 && (a0 + 4 * fq + r) == (A.n0 + 16 * t + fr)) ? 1.f : __int_as_float(zo);
    bf16x8 Ar[4][4]; u32x2 Qr[4][NT]; float Gr[4];
#define SR_LOAD(k, i) do { const bf16_t* pp = Pg + (size_t)(i) * 16384; Ar[k][0] = *(const bf16x8*)pp; Ar[k][1] = *(const bf16x8*)(pp + 512); Ar[k][2] = *(const bf16x8*)(pp + 1024); Ar[k][3] = *(const bf16x8*)(pp + 1536); \
        _Pragma("unroll") for (int t = 0; t < NT; ++t) Qr[k][t] = A.Q ? *(const u32x2*)(A.Q + (size_t)(i) * 16384 + t * 2048 + qoff) : (u32x2){(unsigned)zo, (unsigned)zo}; \
        Gr[k] = GL ? GL[i] : 0.f; } while (0)
    __syncthreads();
#pragma unroll
    for (int k = 0; k < 4; ++k) if (k < nsteps) SR_LOAD(k, k);
    for (int c = 0; c < nsteps; c += 4) {
#pragma unroll
        for (int k = 0; k < 4; ++k) { const int i = c + k;
            if (i < nsteps) {
                LAS unsigned char* bufp = lds + (i & 1) * IMG;
#pragma unroll
                for (int t = 0; t < NT; ++t) { const u32x2 sp = pack4(S[t]); *(LAS u32x2*)(bufp + t * 16 * PB + wofs) = sp;
                    if (A.St) *(u32x2*)(A.St + (size_t)i * 16384 + afrag_off(A.n0 + 16 * t + fr, a0 + 4 * fq)) = sp;
                    if (A.Sstep) { float* o = A.Sstep + (size_t)i * 16384 + roff + 16 * t; o[0] = S[t][0]; o[128] = S[t][1]; o[256] = S[t][2]; o[384] = S[t][3]; } }
                asm volatile("s_waitcnt lgkmcnt(0)" ::: "memory"); __builtin_amdgcn_s_barrier(); asm volatile("" ::: "memory");
                const f32x4 zero = {0.f, 0.f, 0.f, 0.f}; const float g = Gr[k];
#pragma unroll
                for (int t = 0; t < NT; ++t) { const LAS unsigned char* rp = bufp + t * 16 * PB + rofs;
                    const bf16x8 b0 = *(const LAS bf16x8*)rp, b1 = *(const LAS bf16x8*)(rp + 64), b2 = *(const LAS bf16x8*)(rp + 128), b3 = *(const LAS bf16x8*)(rp + 192);
                    f32x4 t0 = MFMA16(Ar[k][0], b0, zero); t0 = MFMA16(Ar[k][1], b1, t0);
                    f32x4 t1 = MFMA16(Ar[k][2], b2, zero); t1 = MFMA16(Ar[k][3], b3, t1);
                    const u32x2 pq = Qr[k][t]; f32x4 q; q[0] = bflo(pq.x); q[1] = bfhi(pq.x); q[2] = bflo(pq.y); q[3] = bfhi(pq.y);
                    S[t] = S[t] * g + (t0 + t1) + q; }
                if (i + 4 < nsteps) SR_LOAD(k, i + 4);
            }
        }
    }
#undef SR_LOAD
#pragma unroll
    for (int t = 0; t < NT; ++t) {
        if (A.Fout) { float* o = A.Fout + roff + 16 * t; o[0] = S[t][0]; o[128] = S[t][1]; o[256] = S[t][2]; o[384] = S[t][3]; }
        if (A.Trow) {
#pragma unroll
            for (int r = 0; r < 4; ++r) A.Trow[afrag_off(a0 + 4 * fq + r, A.n0 + 16 * t + fr)] = f2bf1(S[t][r]); }
        if (A.Tcol) *(u32x2*)(A.Tcol + t * 2048 + qoff) = pack4(S[t]);
    }
}
DI void gmlp_unit(const Params& p, int l, int rb, int g, LAS unsigned char* lds, int tid, int lane, int wave) {
    const int r0 = 128 * rb; const bool isS = rb >= 128; const int fr = lane & 15, fq = lane >> 4;
    bf16_t* mix = (bf16_t*)(p.ws + WS_MIX);
    LAS unsigned char* Vi = lds; LAS unsigned char* Ui = lds + 34816;
    __syncthreads();
    { const int row = tid >> 2, seg = tid & 3; const bf16_t* src = mix + (size_t)(r0 + row) * 1024 + g * 128 + seg * 32;
      u32x4 ua[4], va[4];
#pragma unroll
      for (int i = 0; i < 4; ++i) { ua[i] = *(const u32x4*)(src + 8 * i); va[i] = *(const u32x4*)(src + 512 + 8 * i); }
#pragma unroll
      for (int i = 0; i < 4; ++i) { *(LAS u32x4*)(Ui + row * PB + seg * 64 + 16 * i) = ua[i]; *(LAS u32x4*)(Vi + row * PB + seg * 64 + 16 * i) = va[i]; } }
    __syncthreads();
    const bf16_t* Wimg = (const bf16_t*)(p.ws + (isS ? WS_WSS : WS_WSP)) + (size_t)(l * 4 + g) * 16384; const int i0 = 16 * wave;
    bf16x8 af[4];
#pragma unroll
    for (int s = 0; s < 4; ++s) af[s] = *(const bf16x8*)(Wimg + (i0 + fr) * 128 + 32 * s + 8 * fq);
    float bias[4];
#pragma unroll
    for (int r = 0; r < 4; ++r) { const int i = i0 + 4 * fq + r; bias[r] = p.in[I_GBS][(l * 4 + g) * 128 + (isS ? (i & 15) : i)]; }
    f32x4 y[8]; float ss[4] = {0.f, 0.f, 0.f, 0.f};
#pragma unroll
    for (int ct = 0; ct < 8; ++ct) { f32x4 acc = {0.f, 0.f, 0.f, 0.f};
#pragma unroll
        for (int s = 0; s < 4; ++s) acc = MFMA16(af[s], tr_frag(Vi, PB, 32 * s, 16 * ct, lane), acc);
#pragma unroll
        for (int r = 0; r < 4; ++r) { const float uv = bf2f(*(const LAS unsigned short*)(Ui + (i0 + 4 * fq + r) * PB + (16 * ct + fr) * 2)); const float v = uv * (acc[r] + bias[r]); y[ct][r] = v; ss[r] += v * v; } }
#pragma unroll
    for (int r = 0; r < 4; ++r) { float s = ss[r]; s += __shfl_xor(s, 1); s += __shfl_xor(s, 2); s += __shfl_xor(s, 4); s += __shfl_xor(s, 8); ss[r] = rsqrtf(s * (1.f / 128.f) + EPS); }
    float gnv[8];
#pragma unroll
    for (int ct = 0; ct < 8; ++ct) gnv[ct] = p.in[I_GNORM][l * 512 + g * 128 + 16 * ct + fr];
#pragma unroll
    for (int ct = 0; ct < 8; ++ct) { const float gn = gnv[ct];
#pragma unroll
        for (int r = 0; r < 4; ++r) mix[(size_t)(r0 + i0 + 4 * fq + r) * 1024 + g * 128 + 16 * ct + fr] = f2bf1(y[ct][r] * ss[r] * gn); }
}

DI void o_wave(const Params& p, int l, int u, int tt, int lane) {
    bool isS; int h, row0, Lv, b, c; unit_geom(u, isS, h, row0, Lv, b, c);
    const int fr = lane & 15, fq = lane >> 4, t = 16 * tt + fr; const int us = ustore(u);
    const bf16_t* Rg = (const bf16_t*)(p.ws + WS_R) + (size_t)us * 8192; const bf16_t* Sg = (const bf16_t*)(p.ws + WS_ST) + (size_t)us * 16384; const bf16_t* Og = (const bf16_t*)(p.ws + WS_O0) + (size_t)us * 8192;
    const int zrow = row0 + (t < Lv ? t : Lv - 1); const bf16_t* zg = (const bf16_t*)(p.ws + WS_Z) + (size_t)zrow * 512 + h * 128;
    bf16x8 yv[4]; u32x2 zv[8];
#pragma unroll
    for (int s = 0; s < 4; ++s) yv[s] = *(const bf16x8*)(Rg + afrag_off(t, 32 * s + 8 * fq));
#pragma unroll
    for (int nt = 0; nt < 8; ++nt) zv[nt] = *(const u32x2*)(zg + 16 * nt + 4 * fq);
    f32x4 acc[8]; float part = 0.f;
#pragma unroll
    for (int hf = 0; hf < 2; ++hf) {
        bf16x8 xs[4][4]; u32x2 ovv[4];
#pragma unroll
        for (int q = 0; q < 4; ++q) { const int nt = 4 * hf + q;
#pragma unroll
            for (int s = 0; s < 4; ++s) xs[q][s] = *(const bf16x8*)(Sg + afrag_off(16 * nt + fr, 32 * s + 8 * fq));
            ovv[q] = *(const u32x2*)(Og + cfrag_off(t, 16 * nt + 4 * fq)); }
        __builtin_amdgcn_sched_barrier(0);
#pragma unroll
        for (int q = 0; q < 4; ++q) { const int nt = 4 * hf + q; f32x4 a = {0.f, 0.f, 0.f, 0.f};
#pragma unroll
            for (int s = 0; s < 4; ++s) a = MFMA16(xs[q][s], yv[s], a);
            const u32x2 ov = ovv[q];
            a[0] += bflo(ov.x); a[1] += bfhi(ov.x); a[2] += bflo(ov.y); a[3] += bfhi(ov.y);
            acc[nt] = a; part += (a[0] * a[0] + a[1] * a[1]) + (a[2] * a[2] + a[3] * a[3]); }
    }
    part += __shfl_xor(part, 16); part += __shfl_xor(part, 32);
    const float rs = rsqrtf(part * (1.f / 128.f) + EPS);
    f32x4 gnv[8];
#pragma unroll
    for (int nt = 0; nt < 8; ++nt) gnv[nt] = *(const f32x4*)(p.in[I_GDNN] + l * 128 + 16 * nt + 4 * fq);
    if (t < Lv) {
        const int row = row0 + t; bf16_t* mo = (bf16_t*)(p.ws + WS_MIX) + (size_t)row * 1024 + 512 + h * 128;
#pragma unroll
        for (int nt = 0; nt < 8; ++nt) { const int n = 16 * nt + 4 * fq; const f32x4 gn = gnv[nt];
            f32x4 o; o[0] = acc[nt][0] * rs * gn[0] * silu_f(bflo(zv[nt].x)); o[1] = acc[nt][1] * rs * gn[1] * silu_f(bfhi(zv[nt].x)); o[2] = acc[nt][2] * rs * gn[2] * silu_f(bflo(zv[nt].y)); o[3] = acc[nt][3] * rs * gn[3] * silu_f(bfhi(zv[nt].y));
            *(u32x2*)(mo + n) = pack4(o); }
    }
}

#define XB_TMO      128
#define XB_XCNT(j)  (256  + 64 * (j))
#define XB_XSUB(j)  (1280 + 64 * (j))
#define XB_XGEN(j)  (2304 + 64 * (j))
#define XB_TOP      3328
#define XB_TOPGEN   3392
#define XCD_BAR_WORDS 3456
#define XB_SPIN_CAP (1u << 18)

__device__ __forceinline__ unsigned xb_ld(unsigned* p)              { return __hip_atomic_load(p, __ATOMIC_RELAXED, __HIP_MEMORY_SCOPE_AGENT); }
__device__ __forceinline__ unsigned xb_add(unsigned* p, unsigned v) { return __hip_atomic_fetch_add(p, v, __ATOMIC_RELAXED, __HIP_MEMORY_SCOPE_AGENT); }
__device__ __forceinline__ unsigned xb_xcc_id() { return (unsigned)__builtin_amdgcn_s_getreg((3 << 11) | 20) & 0xFu; }
#define XB_SPIN(cond, bar) do { unsigned _sp = 0; while (cond) { __builtin_amdgcn_s_sleep(1); \
    if ((++_sp & 255u) == 0u) { if (xb_ld(&(bar)[XB_TMO])) break; if (_sp > XB_SPIN_CAP) { atomicAdd(&(bar)[XB_TMO], 1u); break; } } } } while (0)

struct XcdBarrier {
    unsigned* bar; unsigned x;
    volatile LAS unsigned* st;
};

__device__ __forceinline__ XcdBarrier xcd_barrier_post(unsigned* bar, volatile LAS unsigned* st) {
    XcdBarrier b; b.bar = bar; b.x = xb_xcc_id(); b.st = st;
    if (threadIdx.x == 0) (void)xb_add(&bar[XB_XCNT(b.x)], 1u);
    return b;
}
__device__ __forceinline__ void xcd_barrier_complete(unsigned* bar, unsigned x, unsigned& nloc, unsigned& nx) {
    const unsigned G = gridDim.x * gridDim.y * gridDim.z;
    unsigned sum, cnt, mine, sp = 0u;
    for (;;) {
        sum = 0u; cnt = 0u; mine = 0u;
#pragma unroll
        for (unsigned j = 0; j < 16; ++j) { const unsigned c = xb_ld(&bar[XB_XCNT(j)]); sum += c; cnt += (c > 0u) ? 1u : 0u; mine = (j == x) ? c : mine; }
        if (sum == G) break;
        __builtin_amdgcn_s_sleep(1);
        if ((++sp & 255u) == 0u) { if (xb_ld(&bar[XB_TMO])) break; if (sp > XB_SPIN_CAP) { atomicAdd(&bar[XB_TMO], 1u); break; } }
    }
    nloc = mine > 0u ? mine : 1u; nx = cnt > 0u ? cnt : 1u;
}

__device__ __forceinline__ void xcd_barrier(const XcdBarrier& b) {
    asm volatile("s_waitcnt vmcnt(0)" ::: "memory");
    __syncthreads();
    if (threadIdx.x == 0) {
        unsigned* bar = b.bar;
        __builtin_amdgcn_s_waitcnt(0);
        unsigned nloc = b.st[0], nx = b.st[1];
        if (nloc == 0u) { xcd_barrier_complete(bar, b.x, nloc, nx); b.st[0] = nloc; b.st[1] = nx; }
        const unsigned old = xb_add(&bar[XB_XSUB(b.x)], 1u);
        const unsigned gen = old / nloc;
        if (old + 1u == (gen + 1u) * nloc) {
            __builtin_amdgcn_fence(__ATOMIC_RELEASE, "agent");
            asm volatile("s_waitcnt vmcnt(0)" ::: "memory");
            const unsigned og = xb_add(&bar[XB_TOP], 1u);
            const unsigned tg = og / nx;
            if (og + 1u == (tg + 1u) * nx) xb_add(&bar[XB_TOPGEN], 1u);
            else XB_SPIN(xb_ld(&bar[XB_TOPGEN]) == tg, bar);
            __builtin_amdgcn_fence(__ATOMIC_ACQUIRE, "agent");
            xb_add(&bar[XB_XGEN(b.x)], 1u);
            asm volatile("s_waitcnt vmcnt(0)" ::: "memory");
        } else {
            XB_SPIN(xb_ld(&bar[XB_XGEN(b.x)]) == gen, bar);
            __builtin_amdgcn_fence(__ATOMIC_ACQUIRE, "agent");
            asm volatile("s_waitcnt vmcnt(0)" ::: "memory");
        }
    }
    __syncthreads();
}

__global__ void __launch_bounds__(512, 2) mega_fwd(Params p) {
    extern __shared__ __attribute__((aligned(16))) unsigned char lds_raw[];
    LAS unsigned char* lds = (LAS unsigned char*)lds_raw;
    cg::grid_group grid = cg::this_grid();
    const int G = gridDim.x, blk = blockIdx.x, wave0 = __builtin_amdgcn_readfirstlane((int)threadIdx.x >> 6);
    volatile LAS unsigned* xst = (volatile LAS unsigned*)(lds + L_MISC + 1024);
    if (threadIdx.x < 2) xst[threadIdx.x] = 0u;
    __syncthreads();
    const XcdBarrier xbar = xcd_barrier_post((unsigned*)(p.ws + WS_BAR), xst);
    float* X = p.out; bf16_t* xb = (bf16_t*)(p.ws + WS_XB); float* ssq = (float*)(p.ws + WS_SSQ); bf16_t* mix = (bf16_t*)(p.ws + WS_MIX);
#ifdef DUPMASK
    for (int st = 2 * p.lo; st < 2 * p.hi; ++st) {
        const int ph = st >> 1, rep = st & 1;
        if (rep) { if (ph == 0 || ph == NPH - 1 || !((DUPMASK >> ((ph - 1) % PPL)) & 1)) continue; }
        if (st > 2 * p.lo) { if (st == 2 * p.lo + 2) grid.sync(); else xcd_barrier(xbar); }
#else
    for (int ph = p.lo; ph < p.hi; ++ph) {
        const int rep = 0;
#endif
        int lane_; asm volatile("v_mbcnt_lo_u32_b32 %0, -1, 0\n\tv_mbcnt_hi_u32_b32 %0, -1, %0" : "=v"(lane_));
        const int lane = lane_, wave = wave0, tid = wave * 64 + lane;
#ifdef EXTRA_SYNCS
        if (ph == 1) for (int e = 0; e < EXTRA_SYNCS; ++e) xcd_barrier(xbar);
#endif
        if (ph == 0) phase0(p, lds, tid, lane, wave, G);
        else if (ph == NPH - 1) {
            const int gw = blk * 8 + wave, NGW = G * 8;
            f32x4 fn[4];
#pragma unroll
            for (int j = 0; j < 4; ++j) fn[j] = ((const f32x4*)p.in[I_FN])[lane + 64 * j];
            for (int m = gw; m < M; m += NGW) { const float rs = rowscale(ssq, m); f32x4* xr = (f32x4*)(X + (size_t)m * D); f32x4 xv[4];
#pragma unroll
                for (int j = 0; j < 4; ++j) xv[j] = xr[lane + 64 * j];
#pragma unroll
                for (int j = 0; j < 4; ++j) xr[lane + 64 * j] = xv[j] * rs * fn[j]; }
        } else {
            const int l = (ph - 1) / PPL, k = (ph - 1) % PPL;
            if (k == 0) {
                pg8::Gemm g{xb, (const bf16_t*)(p.ws + WS_WIN), M, NIN, D, D}; pg8::StaticOrder S; S.init(M, NIN, G, blk);
                EpiIn E{ssq, mix, (bf16_t*)(p.ws + WS_QKV), (bf16_t*)(p.ws + WS_Z), (float*)(p.ws + WS_BRAW), p.out + O_CONV_P + (size_t)l * 3 * 1536, p.out + O_CONV_S + (size_t)l * 32 * 3 * 1536, p.out + O_V_S + (size_t)l * 512 * 512};
                pg8::gemm_phase<EpiIn, pg8::StaticOrder, true, true>(lds, g, S, E, tid);
                if (G == 256 && blk >= 90) for (int j = blk - 90; j < 592; j += 166) convert_wg_item(p, l, j, lds, lane, wave);
                else if (G != 256) for (int j = blk; j < 592; j += G) convert_wg_item(p, l, j, lds, lane, wave);
            } else if (k == 1) {
#ifndef DUP_PREP_MODE
#define DUP_PREP_MODE 0
#endif
                if (rep == 0) { for (int u = blk; u < NUNIT; u += G) prep_unit(p, l, u, lds, tid, lane, wave); }
                else { for (int u = blk; u < NUNIT; u += G) prep_unit<DUP_PREP_MODE>(p, l, u, lds, tid, lane, wave); }
            } else if (k == 2) {
                for (int tk = blk; tk < 256; tk += G) {
                    const int x = tk & 7, q = tk >> 3, j = q & 3, hs = (q >> 2) * 8 + x, h = hs >> 4, seg = hs & 15; const size_t u0 = (size_t)h * 256 + 16 * seg;
                    if (seg == 15) continue;
                    ScanArgs a{}; a.P = (const bf16_t*)(p.ws + WS_P) + u0 * 16384; a.G = (const float*)(p.ws + WS_GL) + u0; a.nsteps = 16;
                    if (j < 2) { a.init = 1; a.Q = nullptr; a.Trow = (bf16_t*)(p.ws + WS_TSEG) + (size_t)hs * 16384; a.n0 = 64 * j; }
                    else { a.init = 0; a.Q = (const bf16_t*)(p.ws + WS_Q) + u0 * 16384; a.Tcol = (bf16_t*)(p.ws + WS_BSEG) + (size_t)hs * 16384; a.n0 = 64 * (j - 2); }
                    scan_run<4>(a, lds, lane, wave);
                }
            } else if (k == 3) {
                const bool isScan = ((blk & 7) < 4) && (blk < 64);
                if (isScan) {
                    const int h = blk & 7, sl = blk >> 3;
                    ScanArgs a{}; a.P = (const bf16_t*)(p.ws + WS_TSEG) + (size_t)h * 16 * 16384; a.Q = (const bf16_t*)(p.ws + WS_BSEG) + (size_t)h * 16 * 16384; a.G = nullptr; a.nsteps = 15; a.init = 0;
                    a.Sstep = (float*)(p.ws + WS_SSEG) + (size_t)h * 16 * 16384; a.Fout = (float*)(p.ws + WS_SSEG) + (size_t)(h * 16 + 15) * 16384; a.n0 = 16 * sl;
                    scan_run<1>(a, lds, lane, wave);
                } else {
                    const int fi = (blk < 64) ? blk - (4 * (blk >> 3) + 4) : blk - 32, nf = G - 32;
                    const int n_s = 128, n_g = 528, n_w = (l < 3) ? 208 : 0;
                    for (int it = fi; it < n_s + n_g + n_w; it += nf) {
                        if (it < n_s) { const int b = it >> 2, h = it & 3; const size_t u = 1024 + it, so = (size_t)((l * 32 + b) * 4 + h) * 16384;
                            ScanArgs a{}; a.P = (const bf16_t*)(p.ws + WS_P) + u * 16384; a.Q = (const bf16_t*)(p.ws + WS_Q) + u * 16384; a.G = (const float*)(p.ws + WS_GL) + u; a.nsteps = 1;
                            a.init = 2; a.Sinit = p.in[I_SGDN] + so; a.St = (bf16_t*)(p.ws + WS_ST) + u * 16384; a.Fout = p.out + O_GDN_S + so;
                            a.n0 = 0; scan_run<4>(a, lds, lane, wave); a.n0 = 64; scan_run<4>(a, lds, lane, wave); }
                        else if (it < n_s + n_g) { const int j = it - n_s; if (rep == 0) gmlp_unit(p, l, j >> 2, j & 3, lds, tid, lane, wave); }
                        else convert_wg_item(p, l, 592 + it - n_s - n_g, lds, lane, wave);
                    }
                }
            } else if (k == 4) {
                for (int tk = blk; tk < 256; tk += G) {
                    const int x = tk & 7, q = tk >> 3, j = q & 3, hs = (q >> 2) * 8 + x, h = hs >> 4, seg = hs & 15; const size_t u0 = (size_t)h * 256 + 16 * seg;
                    ScanArgs a{}; a.P = (const bf16_t*)(p.ws + WS_P) + u0 * 16384; a.Q = (const bf16_t*)(p.ws + WS_Q) + u0 * 16384; a.G = (const float*)(p.ws + WS_GL) + u0; a.nsteps = 16;
                    a.init = 2; a.Sinit = (const float*)(p.ws + WS_SSEG) + (size_t)hs * 16384; a.St = (bf16_t*)(p.ws + WS_ST) + u0 * 16384;
                    a.Fout = seg == 15 ? p.out + O_GDN_P + (size_t)(l * 4 + h) * 16384 : nullptr; a.n0 = 32 * j;
                    scan_run<2>(a, lds, lane, wave);
                }
            } else if (k == 5) {
                for (int wt = blk * 8 + wave; wt < NUNIT * 4; wt += G * 8) { if (wt >= 4096 && (wt & 3)) continue; o_wave(p, l, wt >> 2, wt & 3, lane); }
            } else if (k == 6 || k == 7 || k == 10 || k == 11) {
                const bool dn = k >= 10, piece = (k == 7 || k == 11); const bf16_t* Ap = dn ? (const bf16_t*)(p.ws + WS_ACT) : mix; const bf16_t* Bp = (const bf16_t*)(p.ws + (dn ? WS_WD : WS_WO)); const int Kd = dn ? DFF : D;
                pg8::Gemm g{Ap, Bp, piece ? M : MP, D, piece ? 256 : Kd, Kd}; MixOrder S; S.so.init(MP, D, G, blk); S.c = blk; S.nslice = dn ? 11 : 4; S.piece = piece;
                EpiRes2 E{X, xb, ssq, (float*)(p.ws + WS_Q), piece};
                pg8::gemm_phase<EpiRes2, MixOrder, true, true>(lds, g, S, E, tid);
            } else if (k == 8 || k == 12) { sample_finalize(p, k == 12 ? 11 : 4, lane, wave, G);
            } else if (k == 9) {
                pg8::Gemm g{xb, (const bf16_t*)(p.ws + WS_WGU), M, NGU, D, D}; pg8::StaticOrder S; S.init(M, NGU, G, blk);
                EpiGU E{ssq, (bf16_t*)(p.ws + WS_ACT)};
                pg8::gemm_phase<EpiGU, pg8::StaticOrder, true, true>(lds, g, S, E, tid);
            }
        }
#ifdef DBG_DUMP
        if (ph == DBG_DUMP) { const bf16_t* P_ = (const bf16_t*)(p.ws + WS_P); const bf16_t* Q_ = (const bf16_t*)(p.ws + WS_Q); const bf16_t* R_ = (const bf16_t*)(p.ws + WS_R); const bf16_t* O_ = (const bf16_t*)(p.ws + WS_O0);
            for (size_t i = (size_t)blk * 512 + tid; i < 8388608; i += (size_t)G * 512)
                p.out[O_GDN_S + i] = bf2f(P_[i]) + bf2f(Q_[i]) + bf2f(P_[i + 640 * 16384]) + bf2f(Q_[i + 640 * 16384]) + bf2f(R_[i]) + bf2f(O_[i]) + bf2f(R_[i + 128 * 8192]) + bf2f(O_[i + 128 * 8192]); }
#endif
#ifndef DUPMASK
        const int kn = (ph >= 1 && ph + 1 < NPH - 1) ? (ph % PPL) : -1;
        if (ph + 1 < p.hi && kn != 7 && kn != 11) { if (p.hi > 4096) grid.sync(); else xcd_barrier(xbar); }
#endif
    }
}

extern "C" void kernel_launch(void* const* d_in, const int* in_sizes, int n_in, void* d_out, int out_size, void* d_ws, size_t ws_size, hipStream_t stream) {
    static int grid = 0;
    if (grid == 0) {
        if (n_in != 19 || (size_t)out_size != O_END || ws_size < WS_END) { fprintf(stderr, "kernel_launch: shape/workspace mismatch: n_in %d out %d ws %zu (need %zu); nothing launched\n", n_in, out_size, ws_size, (size_t)WS_END); grid = -1; return; }
        int dev = 0, cus = 0, per_cu = 0;
        hipGetDevice(&dev); hipDeviceGetAttribute(&cus, hipDeviceAttributeMultiprocessorCount, dev);
        if (hipFuncSetAttribute((const void*)mega_fwd, hipFuncAttributeMaxDynamicSharedMemorySize, LDS_BYTES) != hipSuccess) { fprintf(stderr, "kernel_launch: hipFuncSetAttribute failed\n"); grid = -1; return; }
        if (hipOccupancyMaxActiveBlocksPerMultiprocessor(&per_cu, (const void*)mega_fwd, 512, LDS_BYTES) != hipSuccess || per_cu < 1) { fprintf(stderr, "kernel_launch: occupancy query gave %d\n", per_cu); (void)hipGetLastError(); per_cu = 1; }
        grid = cus * (per_cu > 1 ? 1 : per_cu);
        if (grid < 64) { fprintf(stderr, "kernel_launch: grid %d too small\n", grid); grid = -1; return; }
    }
    if (grid < 0) return;
    Params a{};
    for (int i = 0; i < 19; ++i) a.in[i] = (const float*)d_in[i];
    a.out = (float*)d_out; a.ws = (unsigned char*)d_ws;
#if ONE_LAUNCH
    if (hipMemsetAsync((char*)d_ws + WS_BAR, 0, 16384, stream) != hipSuccess) { fprintf(stderr, "kernel_launch: memset of the barrier words failed\n"); return; }
    a.lo = 0; a.hi = NPH;
    void* args[] = {&a};
    hipError_t e = hipLaunchCooperativeKernel((const void*)mega_fwd, dim3(grid), dim3(512), args, LDS_BYTES, stream);
    if (e != hipSuccess) fprintf(stderr, "kernel_launch: cooperative launch failed: %s (grid %d)\n", hipGetErrorString(e), grid);
#else
    for (int ph = 0; ph < NPH; ++ph) {
#ifdef DBG_KMAX
        if (ph != 0 && ph != NPH - 1) { const int l_ = (ph - 1) / PPL, k_ = (ph - 1) % PPL; if (l_ > DBG_LMAX || (l_ == DBG_LMAX && k_ > DBG_KMAX)) continue; }
#endif
        a.lo = ph; a.hi = ph + 1; hipLaunchKernelGGL(mega_fwd, dim3(grid), dim3(512), LDS_BYTES, stream, a); }
#endif
}
```

```cpp
#include <hip/hip_runtime.h>
#include <hip/hip_cooperative_groups.h>
#include <cstdio>
#include <cstdint>
namespace cg = cooperative_groups;
namespace pg8 {
#define PG8_LAS __attribute__((address_space(3)))
typedef unsigned short bf16_t;
typedef short bf16x8 __attribute__((ext_vector_type(8)));
typedef float f32x4 __attribute__((ext_vector_type(4)));
typedef unsigned u32x4 __attribute__((ext_vector_type(4)));
constexpr int BM = 256, BK = 64, HALF = 128, HTB = HALF * BK * 2  , STAGE_BYTES = 8 * HTB, NXCD = 8, WGM = 8;

__host__ __device__ __forceinline__ int lds_byte(int r, int c) { const int st = (r >> 4) * 2 + (c >> 5), rr = r & 15, cc = c & 31, ob = rr * 64 + cc * 2; return st * 1024 + (ob ^ (((ob >> 9) & 1) << 5)); }
__host__ __device__ __forceinline__ void stage_rc(int b, int& R, int& C) { const int st = b / 1024, sb = b % 1024, swz = sb ^ (((sb >> 9) & 1) << 5); R = (st >> 1) * 16 + swz / 64; C = (st & 1) * 32 + (swz % 64) / 2; }
__host__ __device__ __forceinline__ int perm32(int rho) { const int n = rho >> 4, i = rho & 15; return 8 * (i >> 2) + 4 * n + (i & 3); }

struct Unit { int pm, pn, koff; };
struct Gemm { const bf16_t* A; const bf16_t* Bt; int M, N, K, ld; };

struct StaticOrder {
    int nM, nN, nwg, G, c;
    __host__ __device__ void init(int M, int N, int G_, int c_) { nM = M / BM; nN = N / BM; nwg = nM * nN; G = G_; c = c_; }
    __host__ __device__ bool next(int i, Unit& u) const {
        const long L = (long)i * G + c; if (L >= nwg) return false;
        int wgid = (int)L; { const int q = nwg / NXCD, r = nwg % NXCD, xcd = wgid % NXCD, off = wgid / NXCD; wgid = (xcd < r ? xcd * (q + 1) : r * (q + 1) + (xcd - r) * q) + off; }
        const int nig = WGM * nN, gid = wgid / nig, fm = gid * WGM, gsz = (nM - fm) < WGM ? (nM - fm) : WGM;
        u.pm = fm + ((wgid % nig) % gsz); u.pn = (wgid % nig) / gsz; u.koff = 0; return true;
    }
    __device__ __forceinline__ void a_ready(const Unit&) const {}
    __device__ __forceinline__ void done(const Unit&) const {}
};

typedef float f32x2_t __attribute__((ext_vector_type(2))); typedef __bf16 bf16x2_t __attribute__((ext_vector_type(2)));
__device__ __forceinline__ unsigned cvt_pk_bf16(float lo, float hi) { f32x2_t v = {lo, hi}; bf16x2_t b = __builtin_convertvector(v, bf16x2_t); return __builtin_bit_cast(unsigned, b); }

template <class Epi, class Sched, bool ALIGN_EPI = false, bool SP2 = false>
__device__ __forceinline__ void gemm_phase(PG8_LAS unsigned char* lds, const Gemm g, const Sched& S, const Epi& E, const int tid_arg) {
    int tid_ = tid_arg; asm volatile("" : "+v"(tid_)); const int tid = tid_, wid = __builtin_amdgcn_readfirstlane(tid >> 6), lane = tid & 63, wr = wid >> 2, wc = wid & 3, fr = lane & 15, fq = lane >> 4;
    const int K = g.ld, nt = g.K / BK;
    unsigned voffA[2], voffB[2];
#pragma unroll
    for (int i = 0; i < 2; ++i) { int R, C; stage_rc(tid * 16 + i * 8192, R, C); const int Rb = Epi::PERM ? ((R & ~31) + perm32(R & 31)) : R;
        voffA[i] = (unsigned)(R * K + C) * 2u; voffB[i] = (unsigned)(Rb * K + C) * 2u; }
    const size_t kstep = (size_t)(BK * 2);
    const size_t hstep = (size_t)HALF * K * 2;
    const size_t tstep = 2 * hstep;
    const unsigned ldsw = (unsigned)wid * 1024u;
    const int aoff = lds_byte(wr * 64 + fr, fq * 8), boff = lds_byte(wc * 32 + fr, fq * 8);
#define PG8_SA(b, h) (((b) * 2 + (h)) * HTB)
#define PG8_SB(b, h) ((4 + (b) * 2 + (h)) * HTB)
#define PG8_STAGE(bufoff, gbase, voff) do { _Pragma("unroll") for (int _i = 0; _i < 2; ++_i) \
        __builtin_amdgcn_global_load_lds((const unsigned*)((const char*)(gbase) + (voff)[_i]), (PG8_LAS unsigned*)(lds + (bufoff) + ldsw + _i * 8192), 16, 0, 0); } while (0)
#define PG8_LDA(dst, b, h) do { _Pragma("unroll") for (int m = 0; m < 4; ++m) _Pragma("unroll") for (int k = 0; k < 2; ++k) dst[m][k] = *(const PG8_LAS bf16x8*)(lds + PG8_SA(b, h) + aoff + m * 2048 + k * 1024); } while (0)
#define PG8_LDB(dst, b, h) do { _Pragma("unroll") for (int n = 0; n < 2; ++n) _Pragma("unroll") for (int k = 0; k < 2; ++k) dst[n][k] = *(const PG8_LAS bf16x8*)(lds + PG8_SB(b, h) + boff + n * 2048 + k * 1024); } while (0)
#define PG8_MMA(ai, bj, At, Bt) do { __builtin_amdgcn_s_setprio(1); _Pragma("unroll") for (int m = 0; m < 4; ++m) _Pragma("unroll") for (int n = 0; n < 2; ++n) _Pragma("unroll") for (int k = 0; k < 2; ++k) \
        acc[ai][bj][m][n] = __builtin_amdgcn_mfma_f32_16x16x32_bf16(Bt[n][k], At[m][k], acc[ai][bj][m][n], 0, 0, 0); __builtin_amdgcn_s_setprio(0); } while (0)
#define PG8_WAIT_V(n) asm volatile("s_waitcnt vmcnt(" #n ")" ::: "memory")
#define PG8_WAIT_L(n) asm volatile("s_waitcnt lgkmcnt(" #n ")" ::: "memory")
#define PG8_BAR __builtin_amdgcn_s_barrier()
#define PG8_SCHED __builtin_amdgcn_sched_barrier(0)
    Unit cur, nxt; int ui = 0;
    if (!S.next(0, cur)) return;
    f32x4 acc[2][2][4][2];
#pragma unroll
    for (int a = 0; a < 2; ++a)
#pragma unroll
        for (int b = 0; b < 2; ++b)
#pragma unroll
            for (int m = 0; m < 4; ++m)
#pragma unroll
                for (int n = 0; n < 2; ++n) acc[a][b][m][n] = (f32x4){0.f, 0.f, 0.f, 0.f};
    bf16x8 At[4][2], B0[2][2], B1[2][2];
    const char* cA = (const char*)g.A + (size_t)cur.pm * tstep + (size_t)cur.koff * 2; const char* cB = (const char*)g.Bt + (size_t)cur.pn * tstep + (size_t)cur.koff * 2;
    S.a_ready(cur);
    if constexpr (SP2) {
        PG8_STAGE(PG8_SB(0, 0), cB, voffB); PG8_STAGE(PG8_SB(0, 1), cB + hstep, voffB); PG8_STAGE(PG8_SA(0, 0), cA, voffA); PG8_STAGE(PG8_SA(0, 1), cA + hstep, voffA);
        if (wr == 1) PG8_BAR;
        PG8_WAIT_V(2); PG8_BAR;
        PG8_STAGE(PG8_SB(1, 0), cB + kstep, voffB); PG8_STAGE(PG8_SA(1, 0), cA + kstep, voffA); PG8_STAGE(PG8_SB(1, 1), cB + hstep + kstep, voffB);
        PG8_WAIT_V(6); PG8_BAR;
    } else {
        PG8_STAGE(PG8_SB(0, 0), cB, voffB); PG8_STAGE(PG8_SA(0, 0), cA, voffA); PG8_STAGE(PG8_SB(0, 1), cB + hstep, voffB); PG8_STAGE(PG8_SA(0, 1), cA + hstep, voffA);
        if (wr == 1) PG8_BAR;
        PG8_WAIT_V(4); PG8_BAR;
        PG8_STAGE(PG8_SB(1, 0), cB + kstep, voffB); PG8_STAGE(PG8_SA(1, 0), cA + kstep, voffA); PG8_STAGE(PG8_SB(1, 1), cB + hstep + kstep, voffB);
        PG8_WAIT_V(6); PG8_BAR;
    }
    for (;;) {
        const bool has_next = S.next(ui + 1, nxt);
        const char* nA = has_next ? (const char*)g.A + (size_t)nxt.pm * tstep + (size_t)nxt.koff * 2 : cA; const char* nB = has_next ? (const char*)g.Bt + (size_t)nxt.pn * tstep + (size_t)nxt.koff * 2 : cB;
        for (int t = 0; t < nt; t += 2) {
            const bool last = (t == nt - 2);
            const char* a1 = cA + (size_t)(t + 1) * kstep;
            const char* a2 = last ? nA : cA + (size_t)(t + 2) * kstep; const char* b2 = last ? nB : cB + (size_t)(t + 2) * kstep;
            const char* a3 = a2 + kstep; const char* b3 = b2 + kstep;
            if (last && has_next) S.a_ready(nxt);
            if constexpr (SP2) {
            PG8_LDB(B0, 0, 0); PG8_LDB(B1, 0, 1); PG8_SCHED; PG8_LDA(At, 0, 0); PG8_STAGE(PG8_SA(1, 1), a1 + hstep, voffA);
            PG8_WAIT_V(8); PG8_WAIT_L(0); PG8_BAR; PG8_MMA(0, 0, At, B0); PG8_MMA(0, 1, At, B1); PG8_BAR; PG8_SCHED;
            PG8_LDA(At, 0, 1); PG8_STAGE(PG8_SB(0, 0), b2, voffB); PG8_STAGE(PG8_SB(0, 1), b2 + hstep, voffB); PG8_STAGE(PG8_SA(0, 0), a2, voffA);
            PG8_WAIT_V(8); PG8_WAIT_L(0); PG8_BAR; PG8_MMA(1, 0, At, B0); PG8_MMA(1, 1, At, B1); PG8_BAR; PG8_SCHED;
            PG8_LDB(B0, 1, 0); PG8_LDB(B1, 1, 1); PG8_SCHED; PG8_LDA(At, 1, 0); PG8_STAGE(PG8_SA(0, 1), a2 + hstep, voffA);
            PG8_WAIT_V(8); PG8_WAIT_L(0); PG8_BAR; PG8_MMA(0, 0, At, B0); PG8_MMA(0, 1, At, B1); PG8_BAR; PG8_SCHED;
            PG8_LDA(At, 1, 1); PG8_STAGE(PG8_SB(1, 0), b3, voffB); PG8_STAGE(PG8_SB(1, 1), b3 + hstep, voffB); PG8_STAGE(PG8_SA(1, 0), a3, voffA);
            PG8_WAIT_V(8); PG8_WAIT_L(0); PG8_BAR; PG8_MMA(1, 0, At, B0); PG8_MMA(1, 1, At, B1); PG8_BAR; PG8_SCHED;
            } else {
            PG8_LDB(B0, 0, 0); PG8_SCHED; PG8_LDA(At, 0, 0); PG8_STAGE(PG8_SA(1, 1), a1 + hstep, voffA);
            PG8_WAIT_L(8); PG8_BAR; PG8_WAIT_L(0); PG8_MMA(0, 0, At, B0); PG8_BAR; PG8_SCHED;
            PG8_LDB(B1, 0, 1); PG8_STAGE(PG8_SB(0, 0), b2, voffB);
            PG8_BAR; PG8_WAIT_L(0); PG8_MMA(0, 1, At, B1); PG8_BAR;
            PG8_LDA(At, 0, 1); PG8_STAGE(PG8_SA(0, 0), a2, voffA);
            PG8_BAR; PG8_WAIT_L(0); PG8_MMA(1, 0, At, B0); PG8_BAR; PG8_SCHED;
            PG8_STAGE(PG8_SB(0, 1), b2 + hstep, voffB);
            PG8_WAIT_V(6); PG8_BAR; PG8_MMA(1, 1, At, B1); PG8_BAR;
            PG8_LDB(B0, 1, 0); PG8_SCHED; PG8_LDA(At, 1, 0); PG8_STAGE(PG8_SA(0, 1), a2 + hstep, voffA);
            PG8_WAIT_L(8); PG8_BAR; PG8_WAIT_L(0); PG8_MMA(0, 0, At, B0); PG8_BAR; PG8_SCHED;
            PG8_LDB(B1, 1, 1); PG8_STAGE(PG8_SB(1, 0), b3, voffB);
            PG8_BAR; PG8_WAIT_L(0); PG8_MMA(0, 1, At, B1); PG8_BAR;
            PG8_LDA(At, 1, 1); PG8_STAGE(PG8_SA(1, 0), a3, voffA);
            PG8_BAR; PG8_WAIT_L(0); PG8_MMA(1, 0, At, B0); PG8_BAR; PG8_SCHED;
            PG8_STAGE(PG8_SB(1, 1), b3 + hstep, voffB);
            PG8_WAIT_V(6); PG8_BAR; PG8_MMA(1, 1, At, B1); PG8_BAR;
            }
        }
        if constexpr (ALIGN_EPI) { if (wr == 0) PG8_BAR; }
        if constexpr (!Epi::AFTER_DRAIN) { E(acc, cur, wr, wc, fr, fq); S.done(cur); }
        if (!has_next) break;
#pragma unroll
        for (int a = 0; a < 2; ++a)
#pragma unroll
            for (int b = 0; b < 2; ++b)
#pragma unroll
                for (int m = 0; m < 4; ++m)
#pragma unroll
                    for (int n = 0; n < 2; ++n) acc[a][b][m][n] = (f32x4){0.f, 0.f, 0.f, 0.f};
        cur = nxt; cA = nA; cB = nB; ++ui;
        if constexpr (ALIGN_EPI) { if (wr == 1) PG8_BAR; }
    }
    PG8_WAIT_V(0);
    if constexpr (!ALIGN_EPI) { if (wr == 0) PG8_BAR; }
    PG8_BAR;
    if constexpr (Epi::AFTER_DRAIN) { E.fused(acc, cur, wr, wc, fr, fq, lds, wid, lane); S.done(cur); }
#undef PG8_SA
#undef PG8_SB
#undef PG8_STAGE
#undef PG8_LDA
#undef PG8_LDB
#undef PG8_MMA
#undef PG8_WAIT_V
#undef PG8_WAIT_L
#undef PG8_BAR
#undef PG8_SCHED
}
}

#ifndef ONE_LAUNCH
#define ONE_LAUNCH 1
#endif
#define DI __device__ __forceinline__
#define LAS __attribute__((address_space(3)))
using pg8::bf16_t; using pg8::bf16x8; using pg8::f32x4; using pg8::u32x4; using pg8::cvt_pk_bf16;
typedef unsigned u32x2 __attribute__((ext_vector_type(2)));
typedef short s16x4 __attribute__((ext_vector_type(4)));

constexpr int MP = 16384, MS = 512, M = MP + MS, D = 1024, NIN = 3328, NINSRC = 3080, DFF = 2816, NGU = 5632;
constexpr int NUNIT = 1024 + 128;
constexpr int NPH = 54, PPL = 13;
constexpr float EPS = 1e-6f;
constexpr size_t O_GDN_P = (size_t)M * D, O_CONV_P = O_GDN_P + 262144, O_GDN_S = O_CONV_P + 18432, O_CONV_S = O_GDN_S + 8388608, O_V_S = O_CONV_S + 589824, O_END = O_V_S + 1048576;
constexpr size_t WS_XB = 0, WS_MIX = WS_XB + (size_t)M * D * 2, WS_SSQ = WS_MIX + (size_t)M * D * 2, WS_BRAW = WS_SSQ + (size_t)M * 64, WS_GL = WS_BRAW + (size_t)M * 32,
    WS_WSP = WS_GL + 8192, WS_WSS = WS_WSP + 524288, WS_WIN = WS_WSS + 524288, WS_WO = WS_WIN + (size_t)NIN * D * 2, WS_WGU = WS_WO + (size_t)D * D * 2,
    WS_WD = WS_WGU + (size_t)NGU * D * 2, WS_Z = WS_WD + (size_t)D * DFF * 2, WS_QKV = WS_Z + (size_t)M * 512 * 2, WS_P = WS_QKV + (size_t)M * 1536 * 2,
    WS_Q = WS_P + (size_t)NUNIT * 32768, WS_R = WS_Q + (size_t)NUNIT * 32768, WS_O0 = WS_R + (size_t)NUNIT * 16384, WS_TSEG = WS_O0 + (size_t)NUNIT * 16384, WS_BSEG = WS_TSEG + 64 * 32768, WS_SSEG = WS_BSEG + 64 * 32768, WS_BAR = WS_SSEG + 64 * 65536, WS_END = WS_BAR + 16384;
constexpr size_t WS_ST = WS_QKV;
constexpr size_t WS_ACT = WS_Z;
static_assert((size_t)NUNIT * 32768 <= (size_t)M * 1536 * 2 && WS_ACT + (size_t)M * DFF * 2 <= WS_Q, "overlays");
constexpr int LDS_BYTES = 139264, L_MISC = 131072;

struct Params { const float* in[19]; float* out; unsigned char* ws; int lo, hi; };
enum { I_XP = 0, I_XS, I_SGDN, I_SCONV, I_WIN, I_CONVW, I_ALOG, I_DTB, I_GDNN, I_GWS, I_GBS, I_GNORM, I_WO, I_N1, I_N2, I_WG, I_WU, I_WD, I_FN };

DI float bf2f(unsigned short b) { return __uint_as_float((unsigned)b << 16); }
DI float bflo(unsigned w) { return __uint_as_float(w << 16); }
DI float bfhi(unsigned w) { return __uint_as_float(w & 0xffff0000u); }
DI unsigned short f2bf1(float f) { return (unsigned short)(cvt_pk_bf16(f, 0.f) & 0xffffu); }
DI float silu_f(float x) { return x * __builtin_amdgcn_rcpf(1.f + __expf(-x)); }
DI float sigmoid_f(float x) { return __builtin_amdgcn_rcpf(1.f + __expf(-x)); }
DI float softplus_f(float x) { const float t = __expf(-fabsf(x)); return fmaxf(x, 0.f) + (t < 1e-3f ? t * (1.f - 0.5f * t) : __logf(1.f + t)); }
DI float gelu_f(float x) { const float y = 0.7978845608028654f * (x + 0.044715f * x * x * x); const float e = __expf(2.f * y); return x * (1.f - __builtin_amdgcn_rcpf(e + 1.f)); }
DI float wave_sum(float v) {
#pragma unroll
    for (int o = 1; o < 64; o <<= 1) v += __shfl_xor(v, o);
    return v;
}
DI float rowscale(const float* ssq, int row) {
    const f32x4* s = (const f32x4*)(ssq + (size_t)row * 16); const f32x4 a = s[0], b = s[1], c = s[2], d = s[3];
    const float t = (((a.x + a.y) + (a.z + a.w)) + ((b.x + b.y) + (b.z + b.w))) + (((c.x + c.y) + (c.z + c.w)) + ((d.x + d.y) + (d.z + d.w)));
    return rsqrtf(t * (1.f / 1024.f) + EPS);
}
DI float rowscale4(const float* ssq, int row, int fq) {
    const f32x4 a = ((const f32x4*)(ssq + (size_t)row * 16))[fq]; float t = (a.x + a.y) + (a.z + a.w);
    t += __shfl_xor(t, 16); t += __shfl_xor(t, 32);
    return rsqrtf(t * (1.f / 1024.f) + EPS);
}
DI u32x4 pack8(const f32x4 a, const f32x4 b) { u32x4 w; w.x = cvt_pk_bf16(a[0], a[1]); w.y = cvt_pk_bf16(a[2], a[3]); w.z = cvt_pk_bf16(b[0], b[1]); w.w = cvt_pk_bf16(b[2], b[3]); return w; }
DI u32x2 pack4(const f32x4 a) { u32x2 w; w.x = cvt_pk_bf16(a[0], a[1]); w.y = cvt_pk_bf16(a[2], a[3]); return w; }
#define MFMA16(a, b, c) __builtin_amdgcn_mfma_f32_16x16x32_bf16((a), (b), (c), 0, 0, 0)
typedef short v4i16_t __attribute__((ext_vector_type(4)));
DI bf16x8 tr_frag(const LAS unsigned char* img, int pitch, int k0, int col0, int lane) {
    const int l16 = lane & 15, q = l16 >> 2, pp = l16 & 3, fq = lane >> 4;
    const LAS unsigned char* a0 = img + (k0 + 8 * fq + q) * pitch + (col0 + 4 * pp) * 2;
    const v4i16_t lo = __builtin_amdgcn_ds_read_tr16_b64_v4i16((LAS v4i16_t*)a0);
    const v4i16_t hi = __builtin_amdgcn_ds_read_tr16_b64_v4i16((LAS v4i16_t*)(a0 + 4 * pitch));
    return __builtin_shufflevector(lo, hi, 0, 1, 2, 3, 4, 5, 6, 7);
}

DI void transpose_item(const float* W, int ldn, int k0, int nsrc0, int nvalid, bf16_t* WT, int K, int ndst0, const float* gs, LAS float* scr, int lane) {
    { const int n = lane & 31; const bool ok = nsrc0 + n < nvalid; const float* wp = W + (size_t)(k0 + (lane >> 5)) * ldn + (ok ? nsrc0 + n : 0);
      float v[32];
#pragma unroll
      for (int i = 0; i < 32; ++i) v[i] = ok ? __builtin_nontemporal_load(&wp[(size_t)(2 * i) * ldn]) : 0.f;
      if (gs) {
#pragma unroll
          for (int i = 0; i < 32; ++i) v[i] *= gs[k0 + 2 * i + (lane >> 5)]; }
#pragma unroll
      for (int i = 0; i < 32; ++i) scr[(2 * i + (lane >> 5)) * 33 + n] = v[i]; }
    asm volatile("s_waitcnt lgkmcnt(0)" ::: "memory");
    const int c = lane & 7;
#pragma unroll
    for (int j = 0; j < 4; ++j) { const int n = (lane >> 3) + 8 * j; const LAS float* s = scr + (8 * c) * 33 + n;
        u32x4 o; o.x = cvt_pk_bf16(s[0 * 33], s[1 * 33]); o.y = cvt_pk_bf16(s[2 * 33], s[3 * 33]); o.z = cvt_pk_bf16(s[4 * 33], s[5 * 33]); o.w = cvt_pk_bf16(s[6 * 33], s[7 * 33]);
        *(u32x4*)(WT + (size_t)(ndst0 + n) * K + k0 + 8 * c) = o; }
    asm volatile("s_waitcnt lgkmcnt(0)" ::: "memory");
}
DI void conv_win(const Params& p, int l, int it, LAS float* scr, int lane) {
    const int kb = it / 104, nb = it % 104, nd = 32 * nb; int ns, nvalid = NINSRC;
    if (nd < 1024) { const int g = nd >> 8, r = nd & 255, bj = r >> 7, c = r & 127; ns = bj * 512 + g * 128 + c; }
    else if (nd <= 3072) ns = nd;
    else { ns = 0; nvalid = 0; }
    transpose_item(p.in[I_WIN] + (size_t)l * D * NINSRC, NINSRC, 64 * kb, ns, nvalid, (bf16_t*)(p.ws + WS_WIN), D, nd, p.in[I_N1] + l * D, scr, lane);
}
DI void conv_wo(const Params& p, int l, int it, LAS float* scr, int lane) {
    const int kb = it >> 5, nb = it & 31;
    transpose_item(p.in[I_WO] + (size_t)l * D * D, D, 64 * kb, 32 * nb, D, (bf16_t*)(p.ws + WS_WO), D, 32 * nb, nullptr, scr, lane);
}
DI void conv_wgu(const Params& p, int l, int it, LAS float* scr, int lane) {
    const int kb = it / 176, nb = it % 176, nd = 32 * nb, t = nd >> 8, r = nd & 255, bj = r >> 7, c = r & 127;
    const float* W = (bj ? p.in[I_WU] : p.in[I_WG]) + (size_t)l * D * DFF;
    transpose_item(W, DFF, 64 * kb, 128 * t + c, DFF, (bf16_t*)(p.ws + WS_WGU), D, nd, p.in[I_N2] + l * D, scr, lane);
}
DI void conv_wd(const Params& p, int l, int it, LAS float* scr, int lane) {
    const int kb = it >> 5, nb = it & 31;
    transpose_item(p.in[I_WD] + (size_t)l * DFF * D, D, 64 * kb, 32 * nb, D, (bf16_t*)(p.ws + WS_WD), DFF, 32 * nb, nullptr, scr, lane);
}
DI void convert_wg_item(const Params& p, int l, int j, LAS unsigned char* lds, int lane, int wave) {
    __syncthreads();
    LAS float* scr = (LAS float*)(lds + wave * 16384);
    int w = 8 * j + wave;
    if (w < 512) { conv_wo(p, l, w, scr, lane); return; } w -= 512;
    if (w < 2816) { conv_wgu(p, l, w, scr, lane); return; } w -= 2816;
    if (w < 1408) { conv_wd(p, l, w, scr, lane); return; } w -= 1408;
    if (l < 3 && w < 1664) conv_win(p, l + 1, w, scr, lane);
}

DI void phase0(const Params& p, LAS unsigned char* lds, int tid, int lane, int wave, int G) {
    const int gw = blockIdx.x * 8 + wave, NGW = G * 8;
    LAS float* scr = (LAS float*)(lds + wave * 16384);
    for (int it = gw; it < 1664; it += NGW) conv_win(p, 0, it, scr, lane);
    float* X = p.out; bf16_t* xb = (bf16_t*)(p.ws + WS_XB); float* ssq = (float*)(p.ws + WS_SSQ);
    for (int m = gw; m < M; m += NGW) {
        const float* src = m < MP ? p.in[I_XP] + (size_t)m * D : p.in[I_XS] + (size_t)(m - MP) * D;
        f32x4 v[4]; float s = 0.f;
#pragma unroll
        for (int j = 0; j < 4; ++j) { v[j] = __builtin_nontemporal_load(&((const f32x4*)src)[lane + 64 * j]); s += (v[j].x * v[j].x + v[j].y * v[j].y) + (v[j].z * v[j].z + v[j].w * v[j].w); }
        s = wave_sum(s);
#pragma unroll
        for (int j = 0; j < 4; ++j) ((u32x2*)(xb + (size_t)m * D))[lane + 64 * j] = pack4(v[j]);
        if (lane < 16) ssq[(size_t)m * 16 + lane] = lane == 0 ? s : 0.f;
    }
    bf16_t* wsp = (bf16_t*)(p.ws + WS_WSP); bf16_t* wss = (bf16_t*)(p.ws + WS_WSS); const float* gws = p.in[I_GWS];
    for (int e = blockIdx.x * 512 + tid; e < 16 * 16384; e += G * 512) {
        const int lg = e >> 14, i = (e >> 7) & 127, j = e & 127;
        wsp[e] = ((j >> 6) <= (i >> 6)) ? f2bf1(gws[e]) : (unsigned short)0;
        wss[e] = ((i >> 4) == (j >> 4)) ? f2bf1(gws[(size_t)lg * 16384 + (i & 15) * 128 + (j & 15)]) : (unsigned short)0;
    }
}

struct EpiIn {
    static constexpr bool PERM = true, AFTER_DRAIN = false;
    const float* ssq; bf16_t* mix; bf16_t* qkv; bf16_t* z; float* braw; float* convp; float* convs; float* vs;
    DI void operator()(const f32x4 (&acc)[2][2][4][2], const pg8::Unit& u, int wr, int wc, int fr, int fq) const {
        const int pn = u.pn;
        float rsv[2][4];
#pragma unroll
        for (int ai = 0; ai < 2; ++ai)
#pragma unroll
            for (int m = 0; m < 4; ++m) rsv[ai][m] = rowscale4(ssq, u.pm * 256 + ai * 128 + wr * 64 + m * 16 + fr, fq);
#pragma unroll
        for (int ai = 0; ai < 2; ++ai)
#pragma unroll
            for (int m = 0; m < 4; ++m) {
                const int row = u.pm * 256 + ai * 128 + wr * 64 + m * 16 + fr; const float rs = rsv[ai][m];
                if (pn < 4) {
#pragma unroll
                    for (int bj = 0; bj < 2; ++bj) { f32x4 v0 = acc[ai][bj][m][0] * rs, v1 = acc[ai][bj][m][1] * rs;
#pragma unroll
                        for (int e = 0; e < 4; ++e) { v0[e] = gelu_f(v0[e]); v1[e] = gelu_f(v1[e]); }
                        const int col = pn * 128 + wc * 32 + 8 * fq;
                        *(u32x4*)(mix + (size_t)row * 1024 + bj * 512 + col) = pack8(v0, v1);
                        if (bj == 1 && row >= MP) { float* o = vs + (size_t)(row - MP) * 512 + col; *(f32x4*)o = v0; *(f32x4*)(o + 4) = v1; } }
                } else if (pn < 10) {
#pragma unroll
                    for (int bj = 0; bj < 2; ++bj) { const f32x4 v0 = acc[ai][bj][m][0] * rs, v1 = acc[ai][bj][m][1] * rs;
                        const int j0 = (pn - 4) * 256 + bj * 128 + wc * 32 + 8 * fq;
                        *(u32x4*)(qkv + (size_t)row * 1536 + j0) = pack8(v0, v1);
                        float* cb = nullptr;
                        if (row >= MP) { const int t = (row - MP) & 15; if (t >= 13) cb = convs + ((size_t)((row - MP) >> 4) * 3 + (t - 13)) * 1536 + j0; }
                        else if (row >= MP - 3) cb = convp + (size_t)(row - (MP - 3)) * 1536 + j0;
                        if (cb) { *(f32x4*)cb = v0; *(f32x4*)(cb + 4) = v1; } }
                } else if (pn < 12) {
#pragma unroll
                    for (int bj = 0; bj < 2; ++bj) { const f32x4 v0 = acc[ai][bj][m][0] * rs, v1 = acc[ai][bj][m][1] * rs;
                        *(u32x4*)(z + (size_t)row * 512 + (pn - 10) * 256 + bj * 128 + wc * 32 + 8 * fq) = pack8(v0, v1); }
                } else {
                    if (wc == 0 && fq == 0) { float* o = braw + (size_t)row * 8; *(f32x4*)o = acc[ai][0][m][0] * rs; *(f32x4*)(o + 4) = acc[ai][0][m][1] * rs; }
                }
            }
    }
};
struct EpiRes {
    static constexpr bool PERM = true, AFTER_DRAIN = false;
    float* X; bf16_t* xb; float* ssq; const float* Xr;
    DI void operator()(const f32x4 (&acc)[2][2][4][2], const pg8::Unit& u, int wr, int wc, int fr, int fq) const {
        const int rowb = u.pm * 256 + wr * 64 + fr, colb = u.pn * 256 + wc * 32 + 8 * fq;
        f32x4 cur[4], nxt[4];
        { const float* xp = Xr + (size_t)rowb * D + colb; cur[0] = *(const f32x4*)xp; cur[1] = *(const f32x4*)(xp + 4); cur[2] = *(const f32x4*)(xp + 128); cur[3] = *(const f32x4*)(xp + 132); }
#pragma unroll
        for (int q = 0; q < 8; ++q) { const int ai = q >> 2, m = q & 3;
            const int row = rowb + ai * 128 + m * 16; float part = 0.f;
            if (q < 7) { const int q1 = q + 1; const float* xp = Xr + (size_t)(rowb + (q1 >> 2) * 128 + (q1 & 3) * 16) * D + colb; nxt[0] = *(const f32x4*)xp; nxt[1] = *(const f32x4*)(xp + 4); nxt[2] = *(const f32x4*)(xp + 128); nxt[3] = *(const f32x4*)(xp + 132); }
#pragma unroll
            for (int bj = 0; bj < 2; ++bj) { const int col = colb + bj * 128; float* xp = X + (size_t)row * D + col;
                const f32x4 a = cur[2 * bj] + acc[ai][bj][m][0], b = cur[2 * bj + 1] + acc[ai][bj][m][1];
                *(f32x4*)xp = a; *(f32x4*)(xp + 4) = b; *(u32x4*)(xb + (size_t)row * D + col) = pack8(a, b);
                part += ((a.x * a.x + a.y * a.y) + (a.z * a.z + a.w * a.w)) + ((b.x * b.x + b.y * b.y) + (b.z * b.z + b.w * b.w)); }
            part += __shfl_xor(part, 16); part += __shfl_xor(part, 32);
            if (fq == 0) ssq[(size_t)row * 16 + u.pn * 4 + wc] = part;
#pragma unroll
            for (int e = 0; e < 4; ++e) cur[e] = nxt[e];
        }
    }
};
struct EpiGU {
    static constexpr bool PERM = true, AFTER_DRAIN = false;
    const float* ssq; bf16_t* act;
    DI void operator()(const f32x4 (&acc)[2][2][4][2], const pg8::Unit& u, int wr, int wc, int fr, int fq) const {
        float rsv[2][4];
#pragma unroll
        for (int ai = 0; ai < 2; ++ai)
#pragma unroll
            for (int m = 0; m < 4; ++m) rsv[ai][m] = rowscale4(ssq, u.pm * 256 + ai * 128 + wr * 64 + m * 16 + fr, fq);
#pragma unroll
        for (int ai = 0; ai < 2; ++ai)
#pragma unroll
            for (int m = 0; m < 4; ++m) {
                const int row = u.pm * 256 + ai * 128 + wr * 64 + m * 16 + fr; const float rs = rsv[ai][m];
                f32x4 o[2];
#pragma unroll
                for (int n = 0; n < 2; ++n) { const f32x4 g = acc[ai][0][m][n] * rs, up = acc[ai][1][m][n] * rs;
#pragma unroll
                    for (int e = 0; e < 4; ++e) o[n][e] = silu_f(g[e]) * up[e]; }
                *(u32x4*)(act + (size_t)row * DFF + u.pn * 128 + wc * 32 + 8 * fq) = pack8(o[0], o[1]);
            }
    }
};

struct PieceOrder {
    int c, nslice;
    DI bool next(int i, pg8::Unit& u) const { if (i > 0 || c >= 8 * nslice) return false; const int su = c / nslice, ks = c - su * nslice; u.pm = 64 + (su >> 2); u.pn = su & 3; u.koff = ks * 256; return true; }
    DI void a_ready(const pg8::Unit&) const {}
    DI void done(const pg8::Unit&) const {}
};
struct EpiPart {
    static constexpr bool PERM = true, AFTER_DRAIN = false;
    float* part;
    DI void operator()(const f32x4 (&acc)[2][2][4][2], const pg8::Unit& u, int wr, int wc, int fr, int fq) const {
        float* base = part + (size_t)(u.koff >> 8) * 512 * 1024;
#pragma unroll
        for (int ai = 0; ai < 2; ++ai)
#pragma unroll
            for (int m = 0; m < 4; ++m) { const int row = (u.pm - 64) * 256 + ai * 128 + wr * 64 + m * 16 + fr;
#pragma unroll
                for (int bj = 0; bj < 2; ++bj) { float* o = base + (size_t)row * 1024 + u.pn * 256 + bj * 128 + wc * 32 + 8 * fq; *(f32x4*)o = acc[ai][bj][m][0]; *(f32x4*)(o + 4) = acc[ai][bj][m][1]; } }
    }
};
struct MixOrder {
    pg8::StaticOrder so; int c, nslice; bool piece;
    DI bool next(int i, pg8::Unit& u) const {
        if (!piece) return so.next(i, u);
        if (i > 0 || c >= 8 * nslice) return false; const int su = c / nslice, ks = c - su * nslice; u.pm = 64 + (su >> 2); u.pn = su & 3; u.koff = ks * 256; return true; }
    DI void a_ready(const pg8::Unit&) const {}
    DI void done(const pg8::Unit&) const {}
};
struct EpiRes2 {
    static constexpr bool PERM = true, AFTER_DRAIN = false;
    float* X; bf16_t* xb; float* ssq; float* part; bool piece; const float* Xr;
    DI void operator()(const f32x4 (&acc)[2][2][4][2], const pg8::Unit& u, int wr, int wc, int fr, int fq) const {
        if (piece) { EpiPart e{part}; e(acc, u, wr, wc, fr, fq); } else { EpiRes e{X, xb, ssq, Xr}; e(acc, u, wr, wc, fr, fq); }
    }
};
DI void sample_finalize(const Params& p, int nslice, const float* xsrc, int lane, int wave, int G) {
    float* X = p.out; bf16_t* xb = (bf16_t*)(p.ws + WS_XB); float* ssq = (float*)(p.ws + WS_SSQ); const float* part = (const float*)(p.ws + WS_Q);
    for (int wt = blockIdx.x * 8 + wave; wt < MS * 4; wt += G * 8) {
        const int rs = wt >> 2, j = wt & 3, m = MP + rs;
        f32x4 v = ((const f32x4*)(xsrc + (size_t)rs * D))[lane + 64 * j];
        f32x4 pv[11];
#pragma unroll
        for (int k = 0; k < 11; ++k) pv[k] = ((const f32x4*)(part + ((size_t)(k < nslice ? k : 0) * 512 + rs) * 1024))[lane + 64 * j];
#pragma unroll
        for (int k = 0; k < 11; ++k) if (k < nslice) v += pv[k];
        const float s = wave_sum((v.x * v.x + v.y * v.y) + (v.z * v.z + v.w * v.w));
        ((f32x4*)(X + (size_t)m * D))[lane + 64 * j] = v; ((u32x2*)(xb + (size_t)m * D))[lane + 64 * j] = pack4(v);
        if (lane < 4) ssq[(size_t)m * 16 + j + 4 * lane] = lane == 0 ? s : 0.f;
    }
}

DI int afrag_off(int r, int k) { return (((r >> 4) * 4 + (k >> 5)) * 64 + ((k & 31) >> 3) * 16 + (r & 15)) * 8 + (k & 7); }
DI int cfrag_off(int n, int a) { return (((n >> 4) * 8 + (a >> 4)) * 64 + ((a & 15) >> 2) * 16 + (n & 15)) * 4 + (a & 3); }
constexpr int PB = 272;
constexpr int L_QS = 0, L_KS = 17408, L_VS = 34816, L_US = 52224, L_WS = 69632, L_MM = 87040, L_AT = 104448, L_PART = 113664, L_BETA = 125952, L_BCUM = L_BETA + 256, L_EBC = L_BCUM + 256, L_SCL = L_EBC + 256;
static_assert(L_SCL + 512 <= L_MISC, "prep LDS");

DI int ustore(int u) { return u < 1024 ? (u & 3) * 256 + (u >> 2) : u; }
DI void unit_geom(int u, bool& isS, int& h, int& row0, int& Lv, int& b, int& c) {
    isS = u >= 1024; h = u & 3;
    if (!isS) { c = u >> 2; b = 0; row0 = 64 * c; Lv = 64; } else { b = (u - 1024) >> 2; c = 0; row0 = MP + 16 * b; Lv = 16; }
}
template <int MODE = 0> DI void prep_unit(const Params& p, int l, int u, LAS unsigned char* lds, int tid_in, int lane_in, int wave) {
    bool isS; int h, row0, Lv, b, c; unit_geom(u, isS, h, row0, Lv, b, c);
    int tid_ = tid_in; asm volatile("" : "+v"(tid_));
    const int tid = tid_, lane = tid & 63; (void)lane_in;
    const int fr = lane & 15, fq = lane >> 4;
    const bf16_t* qkv = (const bf16_t*)(p.ws + WS_QKV);
    LAS float* PART = (LAS float*)(lds + L_PART); LAS float* BETA = (LAS float*)(lds + L_BETA); LAS float* BCUM = (LAS float*)(lds + L_BCUM);
    LAS float* EBC = (LAS float*)(lds + L_EBC); LAS float* SCL = (LAS float*)(lds + L_SCL); LAS float* MM = (LAS float*)(lds + L_MM);
    __syncthreads();
    const int cgp = tid % 48, rseg = tid / 48, which = cgp >> 4, c8 = (cgp & 15) * 8, col = which * 512 + h * 128 + c8;
    const bool actv = tid < 384;
    if (actv) {
        float w[4][8];
        const float* cw = p.in[I_CONVW] + (size_t)l * 4 * 1536 + col;
#pragma unroll
        for (int i = 0; i < 4; ++i) { const f32x4 a = *(const f32x4*)(cw + i * 1536), bb = *(const f32x4*)(cw + i * 1536 + 4);
#pragma unroll
            for (int e = 0; e < 4; ++e) { w[i][e] = a[e]; w[i][4 + e] = bb[e]; } }
        float hx[3][8]; u32x4 raw[11];
#pragma unroll
        for (int j = 0; j < 11; ++j) { int rowi = row0 + 8 * rseg - 3 + j; rowi = rowi < 0 ? 0 : (rowi > M - 1 ? M - 1 : rowi); raw[j] = *(const u32x4*)(qkv + (size_t)rowi * 1536 + col); }
#pragma unroll
        for (int j = 0; j < 3; ++j) { const int tt = 8 * rseg - 3 + j; const bool valid = tt >= 0 ? (tt < Lv) : (!isS && c > 0); const u32x4 r = raw[j];
            hx[j][0] = valid ? bflo(r.x) : 0.f; hx[j][1] = valid ? bfhi(r.x) : 0.f; hx[j][2] = valid ? bflo(r.y) : 0.f; hx[j][3] = valid ? bfhi(r.y) : 0.f;
            hx[j][4] = valid ? bflo(r.z) : 0.f; hx[j][5] = valid ? bfhi(r.z) : 0.f; hx[j][6] = valid ? bflo(r.w) : 0.f; hx[j][7] = valid ? bfhi(r.w) : 0.f; }
        if (isS && rseg == 0) {
#pragma unroll
            for (int j = 0; j < 3; ++j) { const float* sp = p.in[I_SCONV] + ((size_t)(l * 32 + b) * 3 + j) * 1536 + col; const f32x4 a = *(const f32x4*)sp, bb = *(const f32x4*)(sp + 4);
#pragma unroll
                for (int e = 0; e < 4; ++e) { hx[j][e] = a[e]; hx[j][4 + e] = bb[e]; } }
        }
#pragma unroll
        for (int r = 0; r < 8; ++r) { float cur[8]; { const bool valid = 8 * rseg + r < Lv; const u32x4 q = raw[3 + r];
                cur[0] = valid ? bflo(q.x) : 0.f; cur[1] = valid ? bfhi(q.x) : 0.f; cur[2] = valid ? bflo(q.y) : 0.f; cur[3] = valid ? bfhi(q.y) : 0.f;
                cur[4] = valid ? bflo(q.z) : 0.f; cur[5] = valid ? bfhi(q.z) : 0.f; cur[6] = valid ? bflo(q.w) : 0.f; cur[7] = valid ? bfhi(q.w) : 0.f; }
            float s = 0.f;
            float a[8];
#pragma unroll
            for (int e = 0; e < 8; ++e) { const float y = w[0][e] * hx[0][e] + w[1][e] * hx[1][e] + w[2][e] * hx[2][e] + w[3][e] * cur[e]; a[e] = (8 * rseg + r < Lv) ? silu_f(y) : 0.f; s += a[e] * a[e];
                hx[0][e] = hx[1][e]; hx[1][e] = hx[2][e]; hx[2][e] = cur[e]; }
            if (which < 2) PART[(8 * rseg + r) * 48 + cgp] = s;
            u32x4 o; o.x = cvt_pk_bf16(a[0], a[1]); o.y = cvt_pk_bf16(a[2], a[3]); o.z = cvt_pk_bf16(a[4], a[5]); o.w = cvt_pk_bf16(a[6], a[7]);
            *(LAS u32x4*)(lds + which * 17408 + (8 * rseg + r) * PB + c8 * 2) = o; }
    }
    if (tid < 64) {
        const int row = tid; float beta = 0.f, g = 0.f;
        if (row < Lv) { const float* br = (const float*)(p.ws + WS_BRAW) + (size_t)(row0 + row) * 8; beta = sigmoid_f(br[h]);
            g = -__expf(p.in[I_ALOG][l * 4 + h]) * softplus_f(br[4 + h] + p.in[I_DTB][l * 4 + h]); }
        float cs = g;
#pragma unroll
        for (int o = 1; o < 64; o <<= 1) { const float t = __shfl_up(cs, o); if (lane >= o) cs += t; }
        BETA[row] = beta; BCUM[row] = cs; EBC[row] = __expf(cs);
        const float bl = __shfl(cs, 63);
        if (lane == 0 && MODE == 0) ((float*)(p.ws + WS_GL))[ustore(u)] = __expf(bl);
    }
    __syncthreads();
    if (tid < 128) { const int row = tid >> 1, wh = tid & 1; float s = 0.f;
#pragma unroll
        for (int i = 0; i < 16; ++i) s += PART[row * 48 + wh * 16 + i];
        SCL[row * 2 + wh] = rsqrtf(s + EPS) * (wh == 0 ? 0.08838834764831845f : 1.f); }
    __syncthreads();
    {
        const int mat = wave >> 2, it = wave & 3; const LAS unsigned char* Ai = lds + (mat ? L_QS : L_KS);
        bf16x8 af[4];
#pragma unroll
        for (int s = 0; s < 4; ++s) af[s] = *(const LAS bf16x8*)(Ai + (16 * it + fr) * PB + (32 * s + 8 * fq) * 2);
        float rowf[4], bci[4];
#pragma unroll
        for (int r = 0; r < 4; ++r) { const int i = 16 * it + 4 * fq + r; bci[r] = BCUM[i]; rowf[r] = mat ? SCL[i * 2] : BETA[i] * SCL[i * 2 + 1]; }
#pragma unroll
        for (int jt = 0; jt < 4; ++jt) {
            const int j = 16 * jt + fr;
            if (jt > it) {
#pragma unroll
                for (int r = 0; r < 4; ++r) { const int i = 16 * it + 4 * fq + r;
                    if (mat == 0) { MM[i * 68 + j] = 0.f; *(LAS unsigned short*)(lds + L_PART + i * 144 + j * 2) = (unsigned short)0; }
                    else *(LAS unsigned short*)(lds + L_AT + i * 144 + j * 2) = (unsigned short)0; }
                continue;
            }
            f32x4 acc = {0.f, 0.f, 0.f, 0.f};
#pragma unroll
            for (int s = 0; s < 4; ++s) { const bf16x8 bf = *(const LAS bf16x8*)(lds + L_KS + (16 * jt + fr) * PB + (32 * s + 8 * fq) * 2); acc = MFMA16(af[s], bf, acc); }
            const float bcj = BCUM[j], skj = SCL[j * 2 + 1];
#pragma unroll
            for (int r = 0; r < 4; ++r) { const int i = 16 * it + 4 * fq + r; const float dec = (i >= j) ? __expf(bci[r] - bcj) : 0.f; const float v = acc[r] * skj * rowf[r] * dec;
                if (mat == 0) { const float mv = (i > j) ? v : 0.f; MM[i * 68 + j] = mv; *(LAS unsigned short*)(lds + L_PART + i * 144 + j * 2) = (it == jt) ? (unsigned short)0 : f2bf1(mv); }
                else *(LAS unsigned short*)(lds + L_AT + i * 144 + j * 2) = f2bf1(v); }
        }
    }
    __syncthreads();
    LAS unsigned char* DB = lds + L_MISC + 2048;
    if (MODE != 1 && wave < 4) {
        const int b = wave; f32x4 y;
#pragma unroll
        for (int r = 0; r < 4; ++r) y[r] = (4 * fq + r == fr) ? 1.f : 0.f;
#pragma unroll
        for (int g = 0; g < 4; ++g) {
            f32x4 mg[4];
#pragma unroll
            for (int r = 0; r < 4; ++r) mg[r] = *(const LAS f32x4*)(MM + (16 * b + 4 * fq + r) * 68 + 16 * b + 4 * g);
            f32x4 xl; xl[0] = y[0]; xl[1] = y[1] - mg[1][0] * xl[0]; xl[2] = y[2] - mg[2][0] * xl[0] - mg[2][1] * xl[1]; xl[3] = y[3] - mg[3][0] * xl[0] - mg[3][1] * xl[1] - mg[3][2] * xl[2];
            f32x4 xg;
#pragma unroll
            for (int r = 0; r < 4; ++r) xg[r] = __shfl(xl[r], fr + 16 * g);
#pragma unroll
            for (int r = 0; r < 4; ++r) { const float upd = y[r] - (mg[r][0] * xg[0] + mg[r][1] * xg[1] + mg[r][2] * xg[2] + mg[r][3] * xg[3]); y[r] = fq > g ? upd : (fq == g ? xl[r] : y[r]); }
        }
#pragma unroll
        for (int r = 0; r < 4; ++r) { LAS unsigned char* rowp = DB + b * 1280 + (4 * fq + r) * 80; *(LAS unsigned short*)(rowp + (16 * (b & 1) + fr) * 2) = f2bf1(y[r]); *(LAS unsigned short*)(rowp + (16 * (1 - (b & 1)) + fr) * 2) = (unsigned short)0; }
    }
    __syncthreads();
    if (MODE != 1) {
        const LAS unsigned char* MB = lds + L_PART; const f32x4 zero4 = {0.f, 0.f, 0.f, 0.f};
#pragma unroll 1
        for (int cti = 0; cti < 2; ++cti) {
            const int ct = 2 * wave + cti, isw = ct >> 3, c0 = (ct & 7) * 16;
            const LAS unsigned char* src = lds + (isw ? L_KS : L_VS); LAS unsigned char* dst = lds + (isw ? L_WS : L_US);
            { const u32x4 z = {0u, 0u, 0u, 0u}; *(LAS u32x4*)(dst + lane * PB + c0 * 2) = z; *(LAS u32x4*)(dst + lane * PB + c0 * 2 + 16) = z; }
#pragma unroll
            for (int b = 0; b < 4; ++b) {
                if (b > 0 && isS) break;
                f32x4 y;
#pragma unroll
                for (int r = 0; r < 4; ++r) { const int i = 16 * b + 4 * fq + r; float v = bf2f(*(const LAS unsigned short*)(src + i * PB + (c0 + fr) * 2)) * BETA[i]; if (isw) v *= EBC[i] * SCL[i * 2 + 1]; y[r] = v; }
                if (b > 0) {
                    f32x4 t = MFMA16(*(const LAS bf16x8*)(MB + (16 * b + fr) * 144 + 16 * fq), tr_frag(dst, PB, 0, c0, lane), zero4);
                    if (b == 3) t = MFMA16(*(const LAS bf16x8*)(MB + (16 * b + fr) * 144 + 64 + 16 * fq), tr_frag(dst, PB, 32, c0, lane), t);
                    y = y - t;
                }
                LAS unsigned char* xp = dst + (16 * b + 4 * fq) * PB + (c0 + fr) * 2;
#pragma unroll
                for (int r = 0; r < 4; ++r) *(LAS unsigned short*)(xp + r * PB) = f2bf1(y[r]);
                const f32x4 x = MFMA16(*(const LAS bf16x8*)(DB + b * 1280 + fr * 80 + 16 * fq), tr_frag(dst, PB, 32 * (b >> 1), c0, lane), zero4);
#pragma unroll
                for (int r = 0; r < 4; ++r) *(LAS unsigned short*)(xp + r * PB) = f2bf1(x[r]);
            }
        }
    }
    __syncthreads();
    if (MODE == 2) return;
    { const int i = tid >> 3, seg = tid & 7; const float f = __expf(BCUM[63] - BCUM[i]) * SCL[i * 2 + 1]; LAS u32x4* kp = (LAS u32x4*)(lds + L_KS + i * PB + seg * 32);
#pragma unroll
        for (int q = 0; q < 2; ++q) { u32x4 r = kp[q]; r.x = cvt_pk_bf16(bflo(r.x) * f, bfhi(r.x) * f); r.y = cvt_pk_bf16(bflo(r.y) * f, bfhi(r.y) * f); r.z = cvt_pk_bf16(bflo(r.z) * f, bfhi(r.z) * f); r.w = cvt_pk_bf16(bflo(r.w) * f, bfhi(r.w) * f); kp[q] = r; } }
    __syncthreads();
    {
        int lane_ = lane; asm volatile("" : "+v"(lane_));
        const int lane = lane_, fr = lane & 15, fq = lane >> 4;
        const int us = ustore(u);
        bf16_t* Pg = (bf16_t*)(p.ws + WS_P) + (size_t)us * 16384; bf16_t* Qg = (bf16_t*)(p.ws + WS_Q) + (size_t)us * 16384;
        bf16_t* Rg = (bf16_t*)(p.ws + WS_R) + (size_t)us * 8192; bf16_t* Og = (bf16_t*)(p.ws + WS_O0) + (size_t)us * 8192;
        const f32x4 zero = {0.f, 0.f, 0.f, 0.f};
        bf16x8 y0, y1;
        y0 = tr_frag(lds + L_KS, PB, 0, 16 * wave, lane); y1 = tr_frag(lds + L_KS, PB, 32, 16 * wave, lane);
#pragma unroll
        for (int it = 0; it < 8; ++it) { const bf16x8 x0 = tr_frag(lds + L_WS, PB, 0, 16 * it, lane), x1 = tr_frag(lds + L_WS, PB, 32, 16 * it, lane);
            f32x4 a = MFMA16(x0, y0, zero); a = MFMA16(x1, y1, a); a = -a;
            if (MODE == 0 || a[0] == 123.456f) *(u32x2*)(Pg + afrag_off(16 * wave + fr, 16 * it + 4 * fq)) = pack4(a); }
        y0 = tr_frag(lds + L_US, PB, 0, 16 * wave, lane); y1 = tr_frag(lds + L_US, PB, 32, 16 * wave, lane);
#pragma unroll
        for (int it = 0; it < 8; ++it) { const bf16x8 x0 = tr_frag(lds + L_KS, PB, 0, 16 * it, lane), x1 = tr_frag(lds + L_KS, PB, 32, 16 * it, lane);
            f32x4 a = MFMA16(x0, y0, zero); a = MFMA16(x1, y1, a);
            if (MODE == 0 || a[0] == 123.456f) *(u32x2*)(Qg + cfrag_off(16 * wave + fr, 16 * it + 4 * fq)) = pack4(a); }
        const int t0 = 16 * (wave & 3), ib = (wave >> 2) * 4; const int t = t0 + fr;
        y0 = *(const LAS bf16x8*)(lds + L_AT + t * 144 + (8 * fq) * 2); y1 = *(const LAS bf16x8*)(lds + L_AT + t * 144 + (32 + 8 * fq) * 2);
        const float eb = EBC[t] * SCL[t * 2];
#pragma unroll
        for (int q = 0; q < 4; ++q) { const int it = ib + q; const bf16x8 x0 = tr_frag(lds + L_WS, PB, 0, 16 * it, lane), x1 = tr_frag(lds + L_WS, PB, 32, 16 * it, lane);
            f32x4 a = MFMA16(x0, y0, zero); a = MFMA16(x1, y1, a);
            const u32x2 qv = *(const LAS u32x2*)(lds + L_QS + t * PB + (16 * it + 4 * fq) * 2);
            f32x4 rr; rr[0] = bflo(qv.x) * eb - a[0]; rr[1] = bfhi(qv.x) * eb - a[1]; rr[2] = bflo(qv.y) * eb - a[2]; rr[3] = bfhi(qv.y) * eb - a[3];
            if (MODE == 0 || rr[0] == 123.456f) *(u32x2*)(Rg + afrag_off(t, 16 * it + 4 * fq)) = pack4(rr); }
#pragma unroll
        for (int q = 0; q < 4; ++q) { const int it = ib + q; const bf16x8 x0 = tr_frag(lds + L_US, PB, 0, 16 * it, lane), x1 = tr_frag(lds + L_US, PB, 32, 16 * it, lane);
            f32x4 a = MFMA16(x0, y0, zero); a = MFMA16(x1, y1, a);
            if (MODE == 0 || a[0] == 123.456f) *(u32x2*)(Og + cfrag_off(t, 16 * it + 4 * fq)) = pack4(a); }
    }
}

struct ScanArgs {
    const bf16_t* P; const bf16_t* Q; const float* G;
    int nsteps, init;
    const float* Sinit;
    bf16_t* St;
    float* Sstep;
    float* Fout; bf16_t* Trow; bf16_t* Tcol;
    int n0;
};
template <int NT> DI void scan_run(const ScanArgs& A, LAS unsigned char* lds, int lane, int wave) {
    const int fr = lane & 15, fq = lane >> 4, a0 = 16 * wave;
    int zo; asm volatile("v_mov_b32 %0, 0" : "=v"(zo));
    const float* GL = A.G ? A.G + zo : nullptr;
    const bf16_t* Pg = A.P + afrag_off(a0 + fr, 8 * fq);
    const int qoff = cfrag_off(A.n0 + fr, a0 + 4 * fq);
    const int roff = (a0 + 4 * fq) * 128 + A.n0 + fr;
    constexpr int IMG = 16 * NT * PB;
    const int wofs = fr * PB + (a0 + 4 * fq) * 2, rofs = fr * PB + 16 * fq;
    const int nsteps = A.nsteps;
    f32x4 S[NT];
#pragma unroll
    for (int t = 0; t < NT; ++t)
#pragma unroll
        for (int r = 0; r < 4; ++r) S[t][r] = A.init == 2 ? A.Sinit[roff + 16 * t + r * 128] : (A.init == 1 && (a0 + 4 * fq + r) == (A.n0 + 16 * t + fr)) ? 1.f : __int_as_float(zo);
    bf16x8 Ar[4][4]; u32x2 Qr[4][NT]; float Gr[4];
#define SR_LOAD(k, i) do { const bf16_t* pp = Pg + (size_t)(i) * 16384; Ar[k][0] = *(const bf16x8*)pp; Ar[k][1] = *(const bf16x8*)(pp + 512); Ar[k][2] = *(const bf16x8*)(pp + 1024); Ar[k][3] = *(const bf16x8*)(pp + 1536); \
        _Pragma("unroll") for (int t = 0; t < NT; ++t) Qr[k][t] = A.Q ? *(const u32x2*)(A.Q + (size_t)(i) * 16384 + t * 2048 + qoff) : (u32x2){(unsigned)zo, (unsigned)zo}; \
        Gr[k] = GL ? GL[i] : 0.f; } while (0)
    __syncthreads();
#pragma unroll
    for (int k = 0; k < 4; ++k) if (k < nsteps) SR_LOAD(k, k);
    for (int c = 0; c < nsteps; c += 4) {
#pragma unroll
        for (int k = 0; k < 4; ++k) { const int i = c + k;
            if (i < nsteps) {
                LAS unsigned char* bufp = lds + (i & 1) * IMG;
#pragma unroll
                for (int t = 0; t < NT; ++t) { const u32x2 sp = pack4(S[t]); *(LAS u32x2*)(bufp + t * 16 * PB + wofs) = sp;
                    if (A.St) *(u32x2*)(A.St + (size_t)i * 16384 + afrag_off(A.n0 + 16 * t + fr, a0 + 4 * fq)) = sp;
                    if (A.Sstep) { float* o = A.Sstep + (size_t)i * 16384 + roff + 16 * t; o[0] = S[t][0]; o[128] = S[t][1]; o[256] = S[t][2]; o[384] = S[t][3]; } }
                asm volatile("s_waitcnt lgkmcnt(0)" ::: "memory"); __builtin_amdgcn_s_barrier(); asm volatile("" ::: "memory");
                const f32x4 zero = {0.f, 0.f, 0.f, 0.f}; const float g = Gr[k];
#pragma unroll
                for (int t = 0; t < NT; ++t) { const LAS unsigned char* rp = bufp + t * 16 * PB + rofs;
                    const bf16x8 b0 = *(const LAS bf16x8*)rp, b1 = *(const LAS bf16x8*)(rp + 64), b2 = *(const LAS bf16x8*)(rp + 128), b3 = *(const LAS bf16x8*)(rp + 192);
                    f32x4 t0 = MFMA16(Ar[k][0], b0, zero); t0 = MFMA16(Ar[k][1], b1, t0);
                    f32x4 t1 = MFMA16(Ar[k][2], b2, zero); t1 = MFMA16(Ar[k][3], b3, t1);
                    const u32x2 pq = Qr[k][t]; f32x4 q; q[0] = bflo(pq.x); q[1] = bfhi(pq.x); q[2] = bflo(pq.y); q[3] = bfhi(pq.y);
                    S[t] = S[t] * g + (t0 + t1) + q; }
                if (i + 4 < nsteps) SR_LOAD(k, i + 4);
            }
        }
    }
#undef SR_LOAD
#pragma unroll
    for (int t = 0; t < NT; ++t) {
        if (A.Fout) { float* o = A.Fout + roff + 16 * t; o[0] = S[t][0]; o[128] = S[t][1]; o[256] = S[t][2]; o[384] = S[t][3]; }
        if (A.Trow) {
#pragma unroll
            for (int r = 0; r < 4; ++r) A.Trow[afrag_off(a0 + 4 * fq + r, A.n0 + 16 * t + fr)] = f2bf1(S[t][r]); }
        if (A.Tcol) *(u32x2*)(A.Tcol + t * 2048 + qoff) = pack4(S[t]);
    }
}
DI void gmlp_unit(const Params& p, int l, int rb, int g, LAS unsigned char* lds, int tid, int lane, int wave) {
    const int r0 = 128 * rb; const bool isS = rb >= 128; const int fr = lane & 15, fq = lane >> 4;
    bf16_t* mix = (bf16_t*)(p.ws + WS_MIX);
    LAS unsigned char* Vi = lds; LAS unsigned char* Ui = lds + 34816;
    __syncthreads();
    { const int row = tid >> 2, seg = tid & 3; const bf16_t* src = mix + (size_t)(r0 + row) * 1024 + g * 128 + seg * 32;
      u32x4 ua[4], va[4];
#pragma unroll
      for (int i = 0; i < 4; ++i) { ua[i] = *(const u32x4*)(src + 8 * i); va[i] = *(const u32x4*)(src + 512 + 8 * i); }
#pragma unroll
      for (int i = 0; i < 4; ++i) { *(LAS u32x4*)(Ui + row * PB + seg * 64 + 16 * i) = ua[i]; *(LAS u32x4*)(Vi + row * PB + seg * 64 + 16 * i) = va[i]; } }
    __syncthreads();
    const bf16_t* Wimg = (const bf16_t*)(p.ws + (isS ? WS_WSS : WS_WSP)) + (size_t)(l * 4 + g) * 16384; const int i0 = 16 * wave;
    bf16x8 af[4];
#pragma unroll
    for (int s = 0; s < 4; ++s) af[s] = *(const bf16x8*)(Wimg + (i0 + fr) * 128 + 32 * s + 8 * fq);
    float bias[4];
#pragma unroll
    for (int r = 0; r < 4; ++r) { const int i = i0 + 4 * fq + r; bias[r] = p.in[I_GBS][(l * 4 + g) * 128 + (isS ? (i & 15) : i)]; }
    f32x4 y[8]; float ss[4] = {0.f, 0.f, 0.f, 0.f};
#pragma unroll
    for (int ct = 0; ct < 8; ++ct) { f32x4 acc = {0.f, 0.f, 0.f, 0.f};
#pragma unroll
        for (int s = 0; s < 4; ++s) acc = MFMA16(af[s], tr_frag(Vi, PB, 32 * s, 16 * ct, lane), acc);
#pragma unroll
        for (int r = 0; r < 4; ++r) { const float uv = bf2f(*(const LAS unsigned short*)(Ui + (i0 + 4 * fq + r) * PB + (16 * ct + fr) * 2)); const float v = uv * (acc[r] + bias[r]); y[ct][r] = v; ss[r] += v * v; } }
#pragma unroll
    for (int r = 0; r < 4; ++r) { float s = ss[r]; s += __shfl_xor(s, 1); s += __shfl_xor(s, 2); s += __shfl_xor(s, 4); s += __shfl_xor(s, 8); ss[r] = rsqrtf(s * (1.f / 128.f) + EPS); }
    float gnv[8];
#pragma unroll
    for (int ct = 0; ct < 8; ++ct) gnv[ct] = p.in[I_GNORM][l * 512 + g * 128 + 16 * ct + fr];
#pragma unroll
    for (int ct = 0; ct < 8; ++ct) { const float gn = gnv[ct];
#pragma unroll
        for (int r = 0; r < 4; ++r) mix[(size_t)(r0 + i0 + 4 * fq + r) * 1024 + g * 128 + 16 * ct + fr] = f2bf1(y[ct][r] * ss[r] * gn); }
}

DI void o_wave(const Params& p, int l, int u, int tt, int lane) {
    bool isS; int h, row0, Lv, b, c; unit_geom(u, isS, h, row0, Lv, b, c);
    const int fr = lane & 15, fq = lane >> 4, t = 16 * tt + fr; const int us = ustore(u);
    const bf16_t* Rg = (const bf16_t*)(p.ws + WS_R) + (size_t)us * 8192; const bf16_t* Sg = (const bf16_t*)(p.ws + WS_ST) + (size_t)us * 16384; const bf16_t* Og = (const bf16_t*)(p.ws + WS_O0) + (size_t)us * 8192;
    const int zrow = row0 + (t < Lv ? t : Lv - 1); const bf16_t* zg = (const bf16_t*)(p.ws + WS_Z) + (size_t)zrow * 512 + h * 128;
    bf16x8 yv[4]; u32x2 zv[8];
#pragma unroll
    for (int s = 0; s < 4; ++s) yv[s] = *(const bf16x8*)(Rg + afrag_off(t, 32 * s + 8 * fq));
#pragma unroll
    for (int nt = 0; nt < 8; ++nt) zv[nt] = *(const u32x2*)(zg + 16 * nt + 4 * fq);
    f32x4 acc[8]; float part = 0.f;
#pragma unroll
    for (int hf = 0; hf < 2; ++hf) {
        bf16x8 xs[4][4]; u32x2 ovv[4];
#pragma unroll
        for (int q = 0; q < 4; ++q) { const int nt = 4 * hf + q;
#pragma unroll
            for (int s = 0; s < 4; ++s) xs[q][s] = *(const bf16x8*)(Sg + afrag_off(16 * nt + fr, 32 * s + 8 * fq));
            ovv[q] = *(const u32x2*)(Og + cfrag_off(t, 16 * nt + 4 * fq)); }
        __builtin_amdgcn_sched_barrier(0);
#pragma unroll
        for (int q = 0; q < 4; ++q) { const int nt = 4 * hf + q; f32x4 a = {0.f, 0.f, 0.f, 0.f};
#pragma unroll
            for (int s = 0; s < 4; ++s) a = MFMA16(xs[q][s], yv[s], a);
            const u32x2 ov = ovv[q];
            a[0] += bflo(ov.x); a[1] += bfhi(ov.x); a[2] += bflo(ov.y); a[3] += bfhi(ov.y);
            acc[nt] = a; part += (a[0] * a[0] + a[1] * a[1]) + (a[2] * a[2] + a[3] * a[3]); }
    }
    part += __shfl_xor(part, 16); part += __shfl_xor(part, 32);
    const float rs = rsqrtf(part * (1.f / 128.f) + EPS);
    f32x4 gnv[8];
#pragma unroll
    for (int nt = 0; nt < 8; ++nt) gnv[nt] = *(const f32x4*)(p.in[I_GDNN] + l * 128 + 16 * nt + 4 * fq);
    if (t < Lv) {
        const int row = row0 + t; bf16_t* mo = (bf16_t*)(p.ws + WS_MIX) + (size_t)row * 1024 + 512 + h * 128;
#pragma unroll
        for (int nt = 0; nt < 8; ++nt) { const int n = 16 * nt + 4 * fq; const f32x4 gn = gnv[nt];
            f32x4 o; o[0] = acc[nt][0] * rs * gn[0] * silu_f(bflo(zv[nt].x)); o[1] = acc[nt][1] * rs * gn[1] * silu_f(bfhi(zv[nt].x)); o[2] = acc[nt][2] * rs * gn[2] * silu_f(bflo(zv[nt].y)); o[3] = acc[nt][3] * rs * gn[3] * silu_f(bfhi(zv[nt].y));
            *(u32x2*)(mo + n) = pack4(o); }
    }
}

#define XB_TMO      128
#define XB_XCNT(j)  (256  + 64 * (j))
#define XB_XSUB(j)  (1280 + 64 * (j))
#define XB_XGEN(j)  (2304 + 64 * (j))
#define XB_TOP      3328
#define XB_TOPGEN   3392
#define XCD_BAR_WORDS 3456
#define XB_SPIN_CAP (1u << 18)

__device__ __forceinline__ unsigned xb_ld(unsigned* p)              { return __hip_atomic_load(p, __ATOMIC_RELAXED, __HIP_MEMORY_SCOPE_AGENT); }
__device__ __forceinline__ unsigned xb_add(unsigned* p, unsigned v) { return __hip_atomic_fetch_add(p, v, __ATOMIC_RELAXED, __HIP_MEMORY_SCOPE_AGENT); }
__device__ __forceinline__ unsigned xb_xcc_id() { return (unsigned)__builtin_amdgcn_s_getreg((3 << 11) | 20) & 0xFu; }
#define XB_SPIN(cond, bar) do { unsigned _sp = 0; while (cond) { __builtin_amdgcn_s_sleep(1); \
    if ((++_sp & 255u) == 0u) { if (xb_ld(&(bar)[XB_TMO])) break; if (_sp > XB_SPIN_CAP) { atomicAdd(&(bar)[XB_TMO], 1u); break; } } } } while (0)

struct XcdBarrier {
    unsigned* bar; unsigned x;
    volatile LAS unsigned* st;
};

__device__ __forceinline__ XcdBarrier xcd_barrier_post(unsigned* bar, volatile LAS unsigned* st) {
    XcdBarrier b; b.bar = bar; b.x = xb_xcc_id(); b.st = st;
    if (threadIdx.x == 0) (void)xb_add(&bar[XB_XCNT(b.x)], 1u);
    return b;
}
__device__ __forceinline__ void xcd_barrier_complete(unsigned* bar, unsigned x, unsigned& nloc, unsigned& nx) {
    const unsigned G = gridDim.x * gridDim.y * gridDim.z;
    unsigned sum, cnt, mine, sp = 0u;
    for (;;) {
        sum = 0u; cnt = 0u; mine = 0u;
#pragma unroll
        for (unsigned j = 0; j < 16; ++j) { const unsigned c = xb_ld(&bar[XB_XCNT(j)]); sum += c; cnt += (c > 0u) ? 1u : 0u; mine = (j == x) ? c : mine; }
        if (sum == G) break;
        __builtin_amdgcn_s_sleep(1);
        if ((++sp & 255u) == 0u) { if (xb_ld(&bar[XB_TMO])) break; if (sp > XB_SPIN_CAP) { atomicAdd(&bar[XB_TMO], 1u); break; } }
    }
    nloc = mine > 0u ? mine : 1u; nx = cnt > 0u ? cnt : 1u;
}

__device__ __forceinline__ void xcd_barrier(const XcdBarrier& b) {
    asm volatile("s_waitcnt vmcnt(0)" ::: "memory");
    __syncthreads();
    if (threadIdx.x == 0) {
        unsigned* bar = b.bar;
        __builtin_amdgcn_s_waitcnt(0);
        unsigned nloc = b.st[0], nx = b.st[1];
        if (nloc == 0u) { xcd_barrier_complete(bar, b.x, nloc, nx); b.st[0] = nloc; b.st[1] = nx; }
        const unsigned old = xb_add(&bar[XB_XSUB(b.x)], 1u);
        const unsigned gen = old / nloc;
        if (old + 1u == (gen + 1u) * nloc) {
            __builtin_amdgcn_fence(__ATOMIC_RELEASE, "agent");
            asm volatile("s_waitcnt vmcnt(0)" ::: "memory");
            const unsigned og = xb_add(&bar[XB_TOP], 1u);
            const unsigned tg = og / nx;
            if (og + 1u == (tg + 1u) * nx) xb_add(&bar[XB_TOPGEN], 1u);
            else XB_SPIN(xb_ld(&bar[XB_TOPGEN]) == tg, bar);
            __builtin_amdgcn_fence(__ATOMIC_ACQUIRE, "agent");
            xb_add(&bar[XB_XGEN(b.x)], 1u);
            asm volatile("s_waitcnt vmcnt(0)" ::: "memory");
        } else {
            XB_SPIN(xb_ld(&bar[XB_XGEN(b.x)]) == gen, bar);
            __builtin_amdgcn_fence(__ATOMIC_ACQUIRE, "agent");
            asm volatile("s_waitcnt vmcnt(0)" ::: "memory");
        }
    }
    __syncthreads();
}

__global__ void __launch_bounds__(512, 2) mega_fwd(Params p) {
    extern __shared__ __attribute__((aligned(16))) unsigned char lds_raw[];
    LAS unsigned char* lds = (LAS unsigned char*)lds_raw;
    cg::grid_group grid = cg::this_grid();
    const int G = gridDim.x, blk = blockIdx.x, wave0 = __builtin_amdgcn_readfirstlane((int)threadIdx.x >> 6);
    volatile LAS unsigned* xst = (volatile LAS unsigned*)(lds + L_MISC + 1024);
    if (threadIdx.x < 2) xst[threadIdx.x] = 0u;
    __syncthreads();
    const XcdBarrier xbar = xcd_barrier_post((unsigned*)(p.ws + WS_BAR), xst);
    float* X = p.out; bf16_t* xb = (bf16_t*)(p.ws + WS_XB); float* ssq = (float*)(p.ws + WS_SSQ); bf16_t* mix = (bf16_t*)(p.ws + WS_MIX);
#ifdef DUPMASK
    for (int st = 2 * p.lo; st < 2 * p.hi; ++st) {
        const int ph = st >> 1, rep = st & 1;
        if (rep) { if (ph == 0 || ph == NPH - 1 || !((DUPMASK >> ((ph - 1) % PPL)) & 1)) continue; }
        if (st > 2 * p.lo) { if (st == 2 * p.lo + 2) grid.sync(); else xcd_barrier(xbar); }
#else
    for (int ph = p.lo; ph < p.hi; ++ph) {
        const int rep = 0;
#endif
        int lane_; asm volatile("v_mbcnt_lo_u32_b32 %0, -1, 0\n\tv_mbcnt_hi_u32_b32 %0, -1, %0" : "=v"(lane_));
        const int lane = lane_, wave = wave0, tid = wave * 64 + lane;
#ifdef EXTRA_SYNCS
        if (ph == 1) for (int e = 0; e < EXTRA_SYNCS; ++e) xcd_barrier(xbar);
#endif
        if (ph == 0) phase0(p, lds, tid, lane, wave, G);
        else if (ph == NPH - 1) {
            const int gw = blk * 8 + wave, NGW = G * 8;
            f32x4 fn[4];
#pragma unroll
            for (int j = 0; j < 4; ++j) fn[j] = ((const f32x4*)p.in[I_FN])[lane + 64 * j];
            for (int m = gw; m < M; m += NGW) { const float rs = rowscale(ssq, m); f32x4* xr = (f32x4*)(X + (size_t)m * D); f32x4 xv[4];
#pragma unroll
                for (int j = 0; j < 4; ++j) xv[j] = xr[lane + 64 * j];
#pragma unroll
                for (int j = 0; j < 4; ++j) xr[lane + 64 * j] = xv[j] * rs * fn[j]; }
        } else {
            const int l = (ph - 1) / PPL, k = (ph - 1) % PPL;
            if (k == 0) {
                pg8::Gemm g{xb, (const bf16_t*)(p.ws + WS_WIN), M, NIN, D, D}; pg8::StaticOrder S; S.init(M, NIN, G, blk);
                EpiIn E{ssq, mix, (bf16_t*)(p.ws + WS_QKV), (bf16_t*)(p.ws + WS_Z), (float*)(p.ws + WS_BRAW), p.out + O_CONV_P + (size_t)l * 3 * 1536, p.out + O_CONV_S + (size_t)l * 32 * 3 * 1536, p.out + O_V_S + (size_t)l * 512 * 512};
                pg8::gemm_phase<EpiIn, pg8::StaticOrder, true, true>(lds, g, S, E, tid);
                if (G == 256 && blk >= 90) for (int j = blk - 90; j < 592; j += 166) convert_wg_item(p, l, j, lds, lane, wave);
                else if (G != 256) for (int j = blk; j < 592; j += G) convert_wg_item(p, l, j, lds, lane, wave);
            } else if (k == 1) {
#ifndef DUP_PREP_MODE
#define DUP_PREP_MODE 0
#endif
                if (rep == 0) { for (int u = blk; u < NUNIT; u += G) prep_unit(p, l, u, lds, tid, lane, wave); }
                else { for (int u = blk; u < NUNIT; u += G) prep_unit<DUP_PREP_MODE>(p, l, u, lds, tid, lane, wave); }
            } else if (k == 2) {
                for (int tk = blk; tk < 256; tk += G) {
                    const int x = tk & 7, q = tk >> 3, j = q & 3, hs = (q >> 2) * 8 + x, h = hs >> 4, seg = hs & 15; const size_t u0 = (size_t)h * 256 + 16 * seg;
                    ScanArgs a{}; a.P = (const bf16_t*)(p.ws + WS_P) + u0 * 16384; a.G = (const float*)(p.ws + WS_GL) + u0; a.nsteps = 16;
                    if (j < 2) { a.init = 1; a.Q = nullptr; a.Trow = (bf16_t*)(p.ws + WS_TSEG) + (size_t)hs * 16384; a.n0 = 64 * j; }
                    else { a.init = 0; a.Q = (const bf16_t*)(p.ws + WS_Q) + u0 * 16384; a.Tcol = (bf16_t*)(p.ws + WS_BSEG) + (size_t)hs * 16384; a.n0 = 64 * (j - 2); }
                    scan_run<4>(a, lds, lane, wave);
                }
            } else if (k == 3) {
                const bool isScan = ((blk & 7) < 4) && (blk < 64);
                if (isScan) {
                    const int h = blk & 7, sl = blk >> 3;
                    ScanArgs a{}; a.P = (const bf16_t*)(p.ws + WS_TSEG) + (size_t)h * 16 * 16384; a.Q = (const bf16_t*)(p.ws + WS_BSEG) + (size_t)h * 16 * 16384; a.G = nullptr; a.nsteps = 15; a.init = 0;
                    a.Sstep = (float*)(p.ws + WS_SSEG) + (size_t)h * 16 * 16384; a.Fout = (float*)(p.ws + WS_SSEG) + (size_t)(h * 16 + 15) * 16384; a.n0 = 16 * sl;
                    scan_run<1>(a, lds, lane, wave);
                } else {
                    const int fi = (blk < 64) ? blk - (4 * (blk >> 3) + 4) : blk - 32, nf = G - 32;
                    const int n_s = 128, n_g = 528, n_w = (l < 3) ? 208 : 0;
                    for (int it = fi; it < n_s + n_g + n_w; it += nf) {
                        if (it < n_s) { const int b = it >> 2, h = it & 3; const size_t u = 1024 + it, so = (size_t)((l * 32 + b) * 4 + h) * 16384;
                            ScanArgs a{}; a.P = (const bf16_t*)(p.ws + WS_P) + u * 16384; a.Q = (const bf16_t*)(p.ws + WS_Q) + u * 16384; a.G = (const float*)(p.ws + WS_GL) + u; a.nsteps = 1;
                            a.init = 2; a.Sinit = p.in[I_SGDN] + so; a.St = (bf16_t*)(p.ws + WS_ST) + u * 16384; a.Fout = p.out + O_GDN_S + so;
                            a.n0 = 0; scan_run<4>(a, lds, lane, wave); a.n0 = 64; scan_run<4>(a, lds, lane, wave); }
                        else if (it < n_s + n_g) { const int j = it - n_s; if (rep == 0) gmlp_unit(p, l, j >> 2, j & 3, lds, tid, lane, wave); }
                        else convert_wg_item(p, l, 592 + it - n_s - n_g, lds, lane, wave);
                    }
                }
            } else if (k == 4) {
                for (int tk = blk; tk < 256; tk += G) {
                    const int x = tk & 7, q = tk >> 3, j = q & 3, hs = (q >> 2) * 8 + x, h = hs >> 4, seg = hs & 15; const size_t u0 = (size_t)h * 256 + 16 * seg;
                    ScanArgs a{}; a.P = (const bf16_t*)(p.ws + WS_P) + u0 * 16384; a.Q = (const bf16_t*)(p.ws + WS_Q) + u0 * 16384; a.G = (const float*)(p.ws + WS_GL) + u0; a.nsteps = 16;
                    a.init = 2; a.Sinit = (const float*)(p.ws + WS_SSEG) + (size_t)hs * 16384; a.St = (bf16_t*)(p.ws + WS_ST) + u0 * 16384;
                    a.Fout = seg == 15 ? p.out + O_GDN_P + (size_t)(l * 4 + h) * 16384 : nullptr; a.n0 = 32 * j;
                    scan_run<2>(a, lds, lane, wave);
                }
            } else if (k == 5) {
                for (int wt = blk * 8 + wave; wt < NUNIT * 4; wt += G * 8) o_wave(p, l, wt >> 2, wt & 3, lane);
            } else if (k == 6 || k == 7 || k == 10 || k == 11) {
                const bool dn = k >= 10, piece = (k == 7 || k == 11); const bf16_t* Ap = dn ? (const bf16_t*)(p.ws + WS_ACT) : mix; const bf16_t* Bp = (const bf16_t*)(p.ws + (dn ? WS_WD : WS_WO)); const int Kd = dn ? DFF : D;
                pg8::Gemm g{Ap, Bp, piece ? M : MP, D, piece ? 256 : Kd, Kd}; MixOrder S; S.so.init(MP, D, G, blk); S.c = blk; S.nslice = dn ? 11 : 4; S.piece = piece;
                EpiRes2 E{X, xb, ssq, (float*)(p.ws + WS_Q), piece, (k == 6 && l == 0) ? p.in[I_XP] : (const float*)X};
                pg8::gemm_phase<EpiRes2, MixOrder, true, true>(lds, g, S, E, tid);
            } else if (k == 8 || k == 12) { sample_finalize(p, k == 12 ? 11 : 4, (k == 8 && l == 0) ? p.in[I_XS] : (const float*)(X + (size_t)MP * D), lane, wave, G);
            } else if (k == 9) {
                pg8::Gemm g{xb, (const bf16_t*)(p.ws + WS_WGU), M, NGU, D, D}; pg8::StaticOrder S; S.init(M, NGU, G, blk);
                EpiGU E{ssq, (bf16_t*)(p.ws + WS_ACT)};
                pg8::gemm_phase<EpiGU, pg8::StaticOrder, true, true>(lds, g, S, E, tid);
            }
        }
#ifdef DBG_DUMP
        if (ph == DBG_DUMP) { const bf16_t* P_ = (const bf16_t*)(p.ws + WS_P); const bf16_t* Q_ = (const bf16_t*)(p.ws + WS_Q); const bf16_t* R_ = (const bf16_t*)(p.ws + WS_R); const bf16_t* O_ = (const bf16_t*)(p.ws + WS_O0);
            for (size_t i = (size_t)blk * 512 + tid; i < 8388608; i += (size_t)G * 512)
                p.out[O_GDN_S + i] = bf2f(P_[i]) + bf2f(Q_[i]) + bf2f(P_[i + 640 * 16384]) + bf2f(Q_[i + 640 * 16384]) + bf2f(R_[i]) + bf2f(O_[i]) + bf2f(R_[i + 128 * 8192]) + bf2f(O_[i + 128 * 8192]); }
#endif
#ifndef DUPMASK
        const int kn = (ph >= 1 && ph + 1 < NPH - 1) ? (ph % PPL) : -1;
        if (ph + 1 < p.hi && kn != 7 && kn != 11) { if (p.hi > 4096) grid.sync(); else xcd_barrier(xbar); }
#endif
    }
}

extern "C" void kernel_launch(void* const* d_in, const int* in_sizes, int n_in, void* d_out, int out_size, void* d_ws, size_t ws_size, hipStream_t stream) {
    static int grid = 0;
    if (grid == 0) {
        if (n_in != 19 || (size_t)out_size != O_END || ws_size < WS_END) { fprintf(stderr, "kernel_launch: shape/workspace mismatch: n_in %d out %d ws %zu (need %zu); nothing launched\n", n_in, out_size, ws_size, (size_t)WS_END); grid = -1; return; }
        int dev = 0, cus = 0, per_cu = 0;
        hipGetDevice(&dev); hipDeviceGetAttribute(&cus, hipDeviceAttributeMultiprocessorCount, dev);
        if (hipFuncSetAttribute((const void*)mega_fwd, hipFuncAttributeMaxDynamicSharedMemorySize, LDS_BYTES) != hipSuccess) { fprintf(stderr, "kernel_launch: hipFuncSetAttribute failed\n"); grid = -1; return; }
        if (hipOccupancyMaxActiveBlocksPerMultiprocessor(&per_cu, (const void*)mega_fwd, 512, LDS_BYTES) != hipSuccess || per_cu < 1) { fprintf(stderr, "kernel_launch: occupancy query gave %d\n", per_cu); (void)hipGetLastError(); per_cu = 1; }
        grid = cus * (per_cu > 1 ? 1 : per_cu);
        if (grid < 64) { fprintf(stderr, "kernel_launch: grid %d too small\n", grid); grid = -1; return; }
    }
    if (grid < 0) return;
    Params a{};
    for (int i = 0; i < 19; ++i) a.in[i] = (const float*)d_in[i];
    a.out = (float*)d_out; a.ws = (unsigned char*)d_ws;
#if ONE_LAUNCH
    if (hipMemsetAsync((char*)d_ws + WS_BAR, 0, 16384, stream) != hipSuccess) { fprintf(stderr, "kernel_launch: memset of the barrier words failed\n"); return; }
    a.lo = 0; a.hi = NPH;
    void* args[] = {&a};
    hipError_t e = hipLaunchCooperativeKernel((const void*)mega_fwd, dim3(grid), dim3(512), args, LDS_BYTES, stream);
    if (e != hipSuccess) fprintf(stderr, "kernel_launch: cooperative launch failed: %s (grid %d)\n", hipGetErrorString(e), grid);
#else
    for (int ph = 0; ph < NPH; ++ph) {
#ifdef DBG_KMAX
        if (ph != 0 && ph != NPH - 1) { const int l_ = (ph - 1) / PPL, k_ = (ph - 1) % PPL; if (l_ > DBG_LMAX || (l_ == DBG_LMAX && k_ > DBG_KMAX)) continue; }
#endif
        a.lo = ph; a.hi = ph + 1; hipLaunchKernelGGL(mega_fwd, dim3(grid), dim3(512), LDS_BYTES, stream, a); }
#endif
}
```
